# Optimizing an MI355X kernel written in HIP

```python
import math
import jax, jax.numpy as jnp
from jax import lax
import numpy as np

D_MODEL = 1024
BATCH = 16
SEQ = 2048
DEPTH = 2
DEC_BATCH = 32
DEC_SEQ = 2048
PAST_LEN = 128

GRID_W = 64
NA_HEADS = 8
NA_HEAD_DIM = 64
NA_W = NA_HEADS * NA_HEAD_DIM
NA_WIN_R = 8
NA_WIN_C = 16
NA_QBLK_C = 16
NA_KBAND_C = 32
ML_HEADS = 4
ML_HEAD_DIM = 128
ML_W = ML_HEADS * ML_HEAD_DIM
ML_CHUNK = 128
EVEN_MIX_W = NA_W + ML_W
EVEN_SPLITS = tuple(int(s) for s in np.cumsum([NA_W] * 3 + [ML_W] * 4))
EVEN_IN = 3 * NA_W + 4 * ML_W + 4 * ML_HEADS
DA_HEADS = 16
DA_HEAD_DIM = 64
DA_W = DA_HEADS * DA_HEAD_DIM
DA_BRANCHES = ((128, 1), (512, 4), (2048, 16))
DA_QBLK = 64
ROPE_THETA = 10000.0
N_EXPERTS = 16
EC_CAPACITY_FACTOR = 2
D_FF_EXPERT = 1408
LN_EPS = 1e-5
DN_ALPHA = (2 * DEPTH) ** 0.25
DN_BETA = (8 * DEPTH) ** -0.25
N_EVEN = (DEPTH + 1) // 2
N_ODD = DEPTH // 2

kernel_name = "hybrid_natten_mlstm_dilated_ec_encoder"


def layer_norm(x, g, b):
    xf = x.astype(jnp.float32)
    mu = xf.mean(-1, keepdims=True)
    var = jnp.square(xf - mu).mean(-1, keepdims=True)
    return ((xf - mu) * lax.rsqrt(var + LN_EPS) * g + b).astype(x.dtype)


def to_heads(a, h):
    B, T, _ = a.shape
    return a.reshape(B, T, h, -1).transpose(0, 2, 1, 3)


def from_heads(a):
    B, H, T, d = a.shape
    return a.transpose(0, 2, 1, 3).reshape(B, T, H * d)


def rope(x):
    T, d = x.shape[2], x.shape[3]
    inv = ROPE_THETA ** (-jnp.arange(0, d, 2, dtype=jnp.float32) / d)
    ang = jnp.arange(T, dtype=jnp.float32)[:, None] * inv[None, :]
    cos, sin = jnp.cos(ang), jnp.sin(ang)
    xf = x.astype(jnp.float32)
    x1, x2 = xf[..., : d // 2], xf[..., d // 2:]
    return jnp.concatenate([x1 * cos - x2 * sin, x1 * sin + x2 * cos], -1).astype(x.dtype)


def neighbourhood_attention(q, k, v, rpb):
    B, H, T, dh = q.shape
    rows = T // GRID_W
    wr = min(NA_WIN_R, rows)
    n_cb = GRID_W // NA_QBLK_C
    qg = (q * dh ** -0.5).reshape(B, H, rows, n_cb, NA_QBLK_C, dh)
    kg = k.reshape(B, H, rows, GRID_W, dh)
    vg = v.reshape(B, H, rows, GRID_W, dh)
    band_start = np.clip(np.arange(n_cb) * NA_QBLK_C - NA_WIN_C // 2, 0, GRID_W - NA_KBAND_C)
    key_col = band_start[:, None] + np.arange(NA_KBAND_C)[None, :]
    q_col = np.arange(GRID_W).reshape(n_cb, NA_QBLK_C)
    win_c0 = np.clip(q_col - NA_WIN_C // 2, 0, GRID_W - NA_WIN_C)
    col_valid = (key_col[:, None, :] >= win_c0[:, :, None]) & (key_col[:, None, :] < win_c0[:, :, None] + NA_WIN_C)
    dc = np.clip(key_col[:, None, :] - q_col[:, :, None] + NA_WIN_C - 1, 0, 2 * NA_WIN_C - 2)
    rpb_c = rpb[:, :, dc].astype(jnp.float32)
    kb = kg[:, :, :, key_col]
    vb = vg[:, :, :, key_col]
    mask = col_valid[None, None, :, :, None, :]

    def one_row(r):
        rs = jnp.clip(r - wr // 2, 0, rows - wr)
        k_r = lax.dynamic_slice_in_dim(kb, rs, wr, axis=2)
        v_r = lax.dynamic_slice_in_dim(vb, rs, wr, axis=2)
        q_r = lax.dynamic_index_in_dim(qg, r, axis=2, keepdims=False)
        s = jnp.einsum('bhcqd,bhwckd->bhcqwk', q_r, k_r, preferred_element_type=jnp.float32)
        dr = rs + jnp.arange(wr) - r + NA_WIN_R - 1
        bias = jnp.take(rpb_c, dr, axis=1).transpose(0, 2, 3, 1, 4)
        s = jnp.where(mask, s + bias[None], -jnp.inf)
        p = jax.nn.softmax(s.reshape(B, H, n_cb, NA_QBLK_C, wr * NA_KBAND_C), axis=-1).reshape(s.shape)
        return jnp.einsum('bhcqwk,bhwckd->bhcqd', p.astype(v.dtype), v_r)

    out = lax.map(one_row, jnp.arange(rows))
    return out.transpose(1, 2, 0, 3, 4, 5).reshape(B, H, T, dh)


def mlstm_direction(q, k, v, log_i, log_f):
    B, H, T, d = q.shape
    L = ML_CHUNK
    nc = T // L

    def chunks(a):
        return jnp.moveaxis(a.reshape(B, H, nc, L, *a.shape[3:]), 2, 0)

    lower = np.tril(np.ones((L, L), dtype=bool))

    def step(carry, inp):
        C, n, m = carry
        qt, kt, vt, it, ft = inp
        b = jnp.cumsum(ft, axis=-1)
        log_d = jnp.where(lower, b[..., :, None] - b[..., None, :] + it[..., None, :], -jnp.inf)
        log_inter = b + m[..., None]
        m_t = jnp.maximum(log_inter, log_d.max(-1))
        w_inter = jnp.exp(log_inter - m_t)
        s = jnp.einsum('bhtd,bhsd->bhts', qt, kt) * jnp.exp(log_d - m_t[..., None])
        num = w_inter[..., None] * jnp.einsum('bhtd,bhde->bhte', qt, C) + jnp.einsum('bhts,bhse->bhte', s, vt)
        den = w_inter * jnp.einsum('bhtd,bhd->bht', qt, n) + s.sum(-1)
        h = num / jnp.maximum(jnp.abs(den), jnp.exp(-m_t))[..., None]
        b_last = b[..., -1]
        log_w = b_last[..., None] - b + it
        m_new = jnp.maximum(b_last + m, log_w.max(-1))
        w_s = jnp.exp(log_w - m_new[..., None])
        decay = jnp.exp(b_last + m - m_new)
        kw = kt * w_s[..., None]
        C_new = decay[..., None, None] * C + jnp.einsum('bhsd,bhse->bhde', kw, vt)
        n_new = decay[..., None] * n + kw.sum(2)
        return (C_new, n_new, m_new), h

    init = (jnp.zeros((B, H, d, d), jnp.float32), jnp.zeros((B, H, d), jnp.float32), jnp.zeros((B, H), jnp.float32))
    _, h = lax.scan(step, init, (chunks(q), chunks(k), chunks(v), chunks(log_i), chunks(log_f)))
    return jnp.moveaxis(h, 0, 2).reshape(B, H, T, d)


def mlstm_bidirectional(q, k, v, i_fwd, i_bwd, f_fwd, f_bwd):
    h_f = mlstm_direction(q, k, v, i_fwd, jax.nn.log_sigmoid(f_fwd))
    fl = lambda a: jnp.flip(a, axis=2)
    h_b = fl(mlstm_direction(fl(q), fl(k), fl(v), fl(i_bwd), fl(jax.nn.log_sigmoid(f_bwd))))
    return h_f + h_b


def even_mixer(x, w_in, gate_bias, rpb, norm_g, w_out):
    B, T, _ = x.shape
    proj = x @ w_in
    qa, ka, va, qb, kb, vb, ob, gates = jnp.split(proj, EVEN_SPLITS, axis=-1)
    ya = from_heads(neighbourhood_attention(to_heads(qa, NA_HEADS), to_heads(ka, NA_HEADS), to_heads(va, NA_HEADS), rpb))
    g = (gates + gate_bias).astype(jnp.float32).reshape(B, T, 4, ML_HEADS).transpose(2, 0, 3, 1)
    qm = to_heads(qb, ML_HEADS).astype(jnp.float32)
    km = to_heads(kb, ML_HEADS).astype(jnp.float32) * ML_HEAD_DIM ** -0.5
    vm = to_heads(vb, ML_HEADS).astype(jnp.float32)
    h = mlstm_bidirectional(qm, km, vm, g[0], g[1], g[2], g[3])
    mu = h.mean(-1, keepdims=True)
    var = jnp.square(h - mu).mean(-1, keepdims=True)
    h = from_heads((h - mu) * lax.rsqrt(var + LN_EPS)) * norm_g
    yb = (jax.nn.sigmoid(ob.astype(jnp.float32)) * h).astype(x.dtype)
    return jnp.concatenate([ya, yb], axis=-1) @ w_out


def dilated_branch(q, k, v, window, dil):
    B, H, T, dh = q.shape
    half = window // (2 * dil)
    n = T // dil
    Q = DA_QBLK
    nb = -(-n // Q)
    nh = -(-half // Q)
    KB = (2 * nh + 1) * Q
    pad_q = nb * Q - n
    sub = lambda a: a.reshape(B, H, n, dil, dh).transpose(0, 1, 3, 2, 4)
    qp = jnp.pad(sub(q), ((0, 0),) * 3 + ((0, pad_q), (0, 0)))
    kp = jnp.pad(sub(k), ((0, 0),) * 3 + ((nh * Q, pad_q + nh * Q), (0, 0)))
    vp = jnp.pad(sub(v), ((0, 0),) * 3 + ((nh * Q, pad_q + nh * Q), (0, 0)))

    def block(j):
        q_j = lax.dynamic_slice_in_dim(qp, j * Q, Q, axis=3)
        k_j = lax.dynamic_slice_in_dim(kp, j * Q, KB, axis=3)
        v_j = lax.dynamic_slice_in_dim(vp, j * Q, KB, axis=3)
        qi = j * Q + jnp.arange(Q)
        ki = j * Q - nh * Q + jnp.arange(KB)
        valid = (jnp.abs(ki[None, :] - qi[:, None]) <= half) & (ki[None, :] >= 0) & (ki[None, :] < n)
        s = jnp.einsum('bhgqd,bhgkd->bhgqk', q_j, k_j, preferred_element_type=jnp.float32)
        s = jnp.where(valid, s, -jnp.inf)
        lse = jax.nn.logsumexp(s, axis=-1)
        o = jnp.einsum('bhgqk,bhgkd->bhgqd', jnp.exp(s - lse[..., None]).astype(v.dtype), v_j)
        return o, lse

    o, lse = lax.map(block, jnp.arange(nb))
    o = jnp.moveaxis(o, 0, 3).reshape(B, H, dil, nb * Q, dh)[:, :, :, :n]
    lse = jnp.moveaxis(lse, 0, 3).reshape(B, H, dil, nb * Q)[:, :, :, :n]
    return o.transpose(0, 1, 3, 2, 4).reshape(B, H, T, dh), lse.transpose(0, 1, 3, 2).reshape(B, H, T)


def odd_mixer(x, w_in, w_out):
    q, k, v = jnp.split(x @ w_in, 3, axis=-1)
    q = rope(to_heads(q, DA_HEADS)) * DA_HEAD_DIM ** -0.5
    k = rope(to_heads(k, DA_HEADS))
    v = to_heads(v, DA_HEADS)
    res = [dilated_branch(q, k, v, w, d) for (w, d) in DA_BRANCHES]
    wts = jax.nn.softmax(jnp.stack([r[1] for r in res]), axis=0)
    o = jnp.einsum('gbht,gbhtd->bhtd', wts, jnp.stack([r[0] for r in res]).astype(jnp.float32))
    return from_heads(o.astype(x.dtype)) @ w_out


def expert_choice_ffn(x, w_router, w_gate, w_up, w_down):
    B, T, D = x.shape
    N = B * T
    cap = EC_CAPACITY_FACTOR * N // N_EXPERTS
    xt = x.reshape(N, D)
    aff = jax.nn.softmax((xt @ w_router).astype(jnp.float32), axis=-1)
    g, idx = lax.top_k(aff.T, cap)
    xe = xt[idx]
    h = jax.nn.silu(jnp.einsum('ecd,edf->ecf', xe, w_gate)) * jnp.einsum('ecd,edf->ecf', xe, w_up)
    ye = jnp.einsum('ecf,efd->ecd', h, w_down) * g[..., None].astype(x.dtype)
    y = jnp.zeros_like(xt).at[idx.reshape(-1)].add(ye.reshape(-1, D))
    return y.reshape(B, T, D)


def setup_inputs(seed: int = 0) -> dict:
    key = jax.random.key(seed)
    ks = jax.random.split(key, 20)
    nrm = lambda k, shape, s: jax.random.normal(k, shape, jnp.float32) * s
    f_bias = jnp.tile(jnp.linspace(3.0, 6.0, ML_HEADS, dtype=jnp.float32), 2)
    gate_base = jnp.concatenate([jnp.zeros((2 * ML_HEADS,), jnp.float32), f_bias])
    return {
        "x_prompt": nrm(ks[0], (BATCH, SEQ, D_MODEL), 1.0),
        "x_sample": nrm(ks[1], (DEC_BATCH, DEC_SEQ, D_MODEL), 1.0),
        "even_w_in": nrm(ks[2], (N_EVEN, D_MODEL, EVEN_IN), D_MODEL ** -0.5),
        "ml_gate_bias": gate_base[None, :] + nrm(ks[3], (N_EVEN, 4 * ML_HEADS), 0.1),
        "na_rpb": nrm(ks[4], (N_EVEN, NA_HEADS, 2 * NA_WIN_R - 1, 2 * NA_WIN_C - 1), 0.3),
        "ml_norm_g": 1.0 + nrm(ks[5], (N_EVEN, ML_W), 0.05),
        "even_w_out": nrm(ks[6], (N_EVEN, EVEN_MIX_W, D_MODEL), EVEN_MIX_W ** -0.5 * DN_BETA),
        "da_w_in": nrm(ks[7], (N_ODD, D_MODEL, 3 * DA_W), D_MODEL ** -0.5),
        "da_w_out": nrm(ks[8], (N_ODD, DA_W, D_MODEL), DA_W ** -0.5 * DN_BETA),
        "ln_mix_g": 1.0 + nrm(ks[9], (DEPTH, D_MODEL), 0.05),
        "ln_mix_b": nrm(ks[10], (DEPTH, D_MODEL), 0.02),
        "ec_router": nrm(ks[11], (DEPTH, D_MODEL, N_EXPERTS), D_MODEL ** -0.5),
        "ec_w_gate": nrm(ks[12], (DEPTH, N_EXPERTS, D_MODEL, D_FF_EXPERT), D_MODEL ** -0.5),
        "ec_w_up": nrm(ks[13], (DEPTH, N_EXPERTS, D_MODEL, D_FF_EXPERT), D_MODEL ** -0.5),
        "ec_w_down": nrm(ks[14], (DEPTH, N_EXPERTS, D_FF_EXPERT, D_MODEL), D_FF_EXPERT ** -0.5 * DN_BETA),
        "ln_ffn_g": 1.0 + nrm(ks[15], (DEPTH, D_MODEL), 0.05),
        "ln_ffn_b": nrm(ks[16], (DEPTH, D_MODEL), 0.02),
    }


def reference(x_prompt, x_sample, even_w_in, ml_gate_bias, na_rpb, ml_norm_g, even_w_out, da_w_in, da_w_out,
              ln_mix_g, ln_mix_b, ec_router, ec_w_gate, ec_w_up, ec_w_down, ln_ffn_g, ln_ffn_b):
    def trunk(x):
        for layer in range(DEPTH):
            if layer % 2 == 0:
                e = layer // 2
                mix = even_mixer(x, even_w_in[e], ml_gate_bias[e], na_rpb[e], ml_norm_g[e], even_w_out[e])
            else:
                o = layer // 2
                mix = odd_mixer(x, da_w_in[o], da_w_out[o])
            x = layer_norm(DN_ALPHA * x + mix, ln_mix_g[layer], ln_mix_b[layer])
            ffn = expert_choice_ffn(x, ec_router[layer], ec_w_gate[layer], ec_w_up[layer], ec_w_down[layer])
            x = layer_norm(DN_ALPHA * x + ffn, ln_ffn_g[layer], ln_ffn_b[layer])
        return x

    y_prompt = trunk(x_prompt)
    y_sample = trunk(x_sample)
    return (y_prompt, y_sample)
```

```cpp
#include <hip/hip_runtime.h>
#include <hip/hip_cooperative_groups.h>
#include <cstdio>
#include <cstring>
namespace cg = cooperative_groups;

#ifndef MULTI_LAUNCH
#define MULTI_LAUNCH 0
#endif

typedef unsigned short u16;
typedef unsigned int u32;
using bf16x8 = __attribute__((ext_vector_type(8))) short;
using s16x4 = __attribute__((ext_vector_type(4))) short;
using f32x4 = __attribute__((ext_vector_type(4))) float;
using u32x4 = __attribute__((ext_vector_type(4))) unsigned;
using u32x2 = __attribute__((ext_vector_type(2))) unsigned;

#define DI __device__ __forceinline__
#define MFMA(a, b, c) __builtin_amdgcn_mfma_f32_16x16x32_bf16((a), (b), (c), 0, 0, 0)

constexpr int NPH_G = 19;
constexpr int NPHASES = 1 + 2 * 10 + 2 * 9;
constexpr int SMEM_BYTES = 155648;
constexpr int NTHR = 512;
constexpr int NWAV = 8;
#define LAS __attribute__((address_space(3)))
constexpr float DN_ALPHA_F = 1.41421356237309515f;
constexpr float LN_EPS_F = 1e-5f;

constexpr size_t OFF_WIN = 0;
constexpr size_t OFF_WOE = OFF_WIN + 7864320;
constexpr size_t OFF_WQKV = OFF_WOE + 2097152;
constexpr size_t OFF_WOO = OFF_WQKV + 6291456;
constexpr size_t OFF_ROPE = OFF_WOO + 2097152;
constexpr size_t OFF_WGU = OFF_ROPE + 524288;
constexpr size_t OFF_WDN = OFF_WGU + 92274688;
constexpr size_t OFF_AFF = OFF_WDN + 46137344;
constexpr size_t OFF_IDX = OFF_AFF + 4194304;
constexpr size_t OFF_GATE = OFF_IDX + 524288;
constexpr size_t OFF_SEL = OFF_GATE + 524288;
constexpr size_t OFF_GATES = OFF_SEL + 4194304;
constexpr size_t OFF_R1 = OFF_GATES + 4194304;
constexpr size_t OFF_X1Q = OFF_R1 + 201326592;
constexpr size_t OFF_R2 = OFF_R1 + 469762048;
constexpr size_t OFF_R3 = OFF_R2 + 134217728;
constexpr size_t OFF_R4 = OFF_R3 + 134217728;
constexpr size_t OFF_BAR = OFF_R4 + 134217728;
constexpr size_t WS_NEEDED = OFF_BAR + 16384;

struct Params {
  const float *x_prompt, *x_sample, *even_w_in, *ml_gate_bias, *na_rpb, *ml_norm_g, *even_w_out, *da_w_in, *da_w_out;
  const float *ln_mix_g, *ln_mix_b, *ec_router, *ec_w_gate, *ec_w_up, *ec_w_down, *ln_ffn_g, *ln_ffn_b;
  float* out;
  char* ws;
};

struct GroupCtx {
  int T, NB, cap;
  const float* xin;
  float* out;
  u16* xb1;
  u16* p1;
};

DI int TIDX() { int t = threadIdx.x; asm volatile("" : "+v"(t)); return t; }
DI int BIDX() { int t = blockIdx.x; asm volatile("" : "+s"(t)); return t; }
DI int GDIM() { int t = gridDim.x; asm volatile("" : "+s"(t)); return t; }
typedef float f32x2_t __attribute__((ext_vector_type(2)));
typedef __bf16 bf16x2_t __attribute__((ext_vector_type(2)));
DI u32 pk(float lo, float hi) { f32x2_t v = {lo, hi}; bf16x2_t b = __builtin_convertvector(v, bf16x2_t); return __builtin_bit_cast(u32, b); }
DI float bflo(u32 w) { return __uint_as_float(w << 16); }
DI float bfhi(u32 w) { return __uint_as_float(w & 0xffff0000u); }
DI bf16x8 ld8(const u16* p) { return *reinterpret_cast<const bf16x8*>(p); }
DI bf16x8 tr_read2(unsigned a0, unsigned a1) {
  s16x4 x, y;
  asm volatile("ds_read_b64_tr_b16 %0, %2\n\tds_read_b64_tr_b16 %1, %3\n\ts_waitcnt lgkmcnt(0)"
               : "=&v"(x), "=&v"(y) : "v"(a0), "v"(a1) : "memory");
  return __builtin_shufflevector(x, y, 0, 1, 2, 3, 4, 5, 6, 7);
}
DI void tr_read_4x2(unsigned base, bf16x8 (&out)[4]) {
  s16x4 x0, y0, x1, y1, x2, y2, x3, y3;
  asm volatile("ds_read_b64_tr_b16 %0, %8\n\t"
               "ds_read_b64_tr_b16 %1, %8 offset:2304\n\t"
               "ds_read_b64_tr_b16 %2, %8 offset:32\n\t"
               "ds_read_b64_tr_b16 %3, %8 offset:2336\n\t"
               "ds_read_b64_tr_b16 %4, %8 offset:64\n\t"
               "ds_read_b64_tr_b16 %5, %8 offset:2368\n\t"
               "ds_read_b64_tr_b16 %6, %8 offset:96\n\t"
               "ds_read_b64_tr_b16 %7, %8 offset:2400\n\t"
               "s_waitcnt lgkmcnt(0)"
               : "=&v"(x0), "=&v"(y0), "=&v"(x1), "=&v"(y1), "=&v"(x2), "=&v"(y2), "=&v"(x3), "=&v"(y3)
               : "v"(base) : "memory");
  out[0] = __builtin_shufflevector(x0, y0, 0, 1, 2, 3, 4, 5, 6, 7);
  out[1] = __builtin_shufflevector(x1, y1, 0, 1, 2, 3, 4, 5, 6, 7);
  out[2] = __builtin_shufflevector(x2, y2, 0, 1, 2, 3, 4, 5, 6, 7);
  out[3] = __builtin_shufflevector(x3, y3, 0, 1, 2, 3, 4, 5, 6, 7);
}
DI bf16x8 pack8(f32x4 a, f32x4 b) {
  u32x4 r; r[0] = pk(a[0], a[1]); r[1] = pk(a[2], a[3]); r[2] = pk(b[0], b[1]); r[3] = pk(b[2], b[3]);
  return __builtin_bit_cast(bf16x8, r);
}
DI float wave_sum(float v) {
#pragma unroll
  for (int o = 32; o >= 1; o >>= 1) v += __shfl_xor(v, o);
  return v;
}

DI int VBID() { const int b = BIDX(), g = GDIM(); return (g & 7) ? b : (b & 7) * (g >> 3) + (b >> 3); }
DI void tile_decode(int item, int NT, int& mt, int& nt) { const int mg = item / (NT * 8), rem = item - mg * (NT * 8); nt = rem >> 3; mt = mg * 8 + (rem & 7); }

template <bool GATHER>
DI void gemm_tile(const u16* __restrict__ A, int lda, const int* __restrict__ ridx, int row0,
                  const u16* __restrict__ Bt, int ldb, int col0, int K, f32x4 (&acc)[8][4], char* smem) {
  const int tid = TIDX(), lane = tid & 63, wid = tid >> 6, wr = wid >> 2, wc = wid & 3, fr = lane & 15, fq = lane >> 4;
  const int r0 = tid >> 3, pc = tid & 7;
  const int c = pc ^ ((r0 >> 1) & 7);
  unsigned pa[4];
#pragma unroll
  for (int i = 0; i < 4; ++i) {
    const int r = r0 + 64 * i;
    if (GATHER) pa[i] = (unsigned)ridx[row0 + r] * (unsigned)lda + c * 8;
    else pa[i] = (unsigned)(row0 + r) * (unsigned)lda + c * 8;
  }
  const u16* pb0 = Bt + (size_t)(col0 + r0) * ldb + c * 8;
  const size_t sb64 = (size_t)64 * ldb;
#pragma unroll
  for (int m = 0; m < 8; ++m)
#pragma unroll
    for (int n = 0; n < 4; ++n) acc[m][n] = f32x4{0.f, 0.f, 0.f, 0.f};
  const int key = (fr >> 1) & 7;
  const int p0 = (fq ^ key) * 16, p1 = ((fq ^ key) ^ 4) * 16;
  const char* rA = smem + (wr * 128 + fr) * 128;
  const char* rB = smem + 65536 + (wc * 64 + fr) * 128;
  LAS char* lds = (LAS char*)smem;
  const int wofs = tid * 16;
  const int nk = K >> 6;
#define G_STAGE(buf_, kt_) { const int ko_ = (kt_) * 64; _Pragma("unroll") for (int i = 0; i < 4; ++i) { \
      __builtin_amdgcn_global_load_lds((const unsigned*)(A + (size_t)pa[i] + ko_), (LAS unsigned*)(lds + (buf_) * 32768 + wofs + i * 8192), 16, 0, 0); \
      __builtin_amdgcn_global_load_lds((const unsigned*)(pb0 + i * sb64 + ko_), (LAS unsigned*)(lds + 65536 + (buf_) * 32768 + wofs + i * 8192), 16, 0, 0); } }
  __syncthreads();
  G_STAGE(0, 0);
  asm volatile("s_waitcnt vmcnt(0)" ::: "memory");
  __syncthreads();
  for (int kt = 0; kt < nk; ++kt) {
    const int cur = kt & 1;
    if (kt + 1 < nk) G_STAGE(cur ^ 1, kt + 1);
    const char* cA = rA + cur * 32768;
    const char* cB = rB + cur * 32768;
#pragma unroll
    for (int ks = 0; ks < 2; ++ks) {
      const int po = ks ? p1 : p0;
      bf16x8 bf[4];
#pragma unroll
      for (int n = 0; n < 4; ++n) bf[n] = *(const bf16x8*)(cB + n * 2048 + po);
#pragma unroll
      for (int mh = 0; mh < 2; ++mh) {
        bf16x8 af[4];
#pragma unroll
        for (int m = 0; m < 4; ++m) af[m] = *(const bf16x8*)(cA + (mh * 4 + m) * 2048 + po);
#pragma unroll
        for (int m = 0; m < 4; ++m)
#pragma unroll
          for (int n = 0; n < 4; ++n) acc[mh * 4 + m][n] = MFMA(bf[n], af[m], acc[mh * 4 + m][n]);
      }
    }
    asm volatile("s_waitcnt vmcnt(0)" ::: "memory");
    __syncthreads();
  }
#undef G_STAGE
}

typedef unsigned char u8;
DI u32 pk4_fp8(float a, float b, float c, float d) {
  int w = __builtin_amdgcn_cvt_pk_fp8_f32(a, b, 0, false);
  w = __builtin_amdgcn_cvt_pk_fp8_f32(c, d, w, true);
  return (u32)w;
}
template <bool GATHER>
DI void gemm_tile_fp8(const u8* __restrict__ A, int lda, const int* __restrict__ ridx, int row0, const u8* __restrict__ Bt, int ldb, int col0, int K,
                      f32x4 (&acc)[8][4], char* smem) {
  const int tid = TIDX(), lane = tid & 63, wid = tid >> 6, wr = wid >> 2, wc = wid & 3, fr = lane & 15, fq = lane >> 4;
  const int r0 = tid >> 3, pc = tid & 7;
  const int c = pc ^ ((r0 >> 1) & 7);
  unsigned pa[4];
#pragma unroll
  for (int i = 0; i < 4; ++i) pa[i] = (GATHER ? (unsigned)ridx[row0 + r0 + 64 * i] : (unsigned)(row0 + r0 + 64 * i)) * (unsigned)lda + c * 16;
  const u8* pb0 = Bt + (size_t)(col0 + r0) * ldb + c * 16;
  const size_t sb64 = (size_t)64 * ldb;
#pragma unroll
  for (int m = 0; m < 8; ++m)
#pragma unroll
    for (int n = 0; n < 4; ++n) acc[m][n] = f32x4{0.f, 0.f, 0.f, 0.f};
  const int key = (fr >> 1) & 7;
  const char* rA = smem + (wr * 128 + fr) * 128;
  const char* rB = smem + 65536 + (wc * 64 + fr) * 128;
  LAS char* lds = (LAS char*)smem;
  const int wofs = tid * 16;
  const int nk = K >> 7;
#define G8_STAGE(buf_, kt_) { const int ko_ = (kt_) * 128; _Pragma("unroll") for (int i = 0; i < 4; ++i) { \
      __builtin_amdgcn_global_load_lds((const unsigned*)(A + (size_t)pa[i] + ko_), (LAS unsigned*)(lds + (buf_) * 32768 + wofs + i * 8192), 16, 0, 0); \
      __builtin_amdgcn_global_load_lds((const unsigned*)(pb0 + i * sb64 + ko_), (LAS unsigned*)(lds + 65536 + (buf_) * 32768 + wofs + i * 8192), 16, 0, 0); } }
  __syncthreads();
  G8_STAGE(0, 0);
  asm volatile("s_waitcnt vmcnt(0)" ::: "memory");
  __syncthreads();
  for (int kt = 0; kt < nk; ++kt) {
    const int cur = kt & 1;
    if (kt + 1 < nk) G8_STAGE(cur ^ 1, kt + 1);
    const char* cA = rA + cur * 32768;
    const char* cB = rB + cur * 32768;
    typedef long long2_t __attribute__((ext_vector_type(2)));
#pragma unroll
    for (int jp = 0; jp < 2; ++jp) {
      const int po = ((4 * jp + fq) ^ key) * 16;
      long2_t bf[4];
#pragma unroll
      for (int n = 0; n < 4; ++n) bf[n] = *(const long2_t*)(cB + n * 2048 + po);
#pragma unroll
      for (int mh = 0; mh < 2; ++mh) {
        long2_t af[4];
#pragma unroll
        for (int m = 0; m < 4; ++m) af[m] = *(const long2_t*)(cA + (mh * 4 + m) * 2048 + po);
#pragma unroll
        for (int m = 0; m < 4; ++m)
#pragma unroll
          for (int n = 0; n < 4; ++n) {
            acc[mh * 4 + m][n] = __builtin_amdgcn_mfma_f32_16x16x32_fp8_fp8(bf[n][0], af[m][0], acc[mh * 4 + m][n], 0, 0, 0);
            acc[mh * 4 + m][n] = __builtin_amdgcn_mfma_f32_16x16x32_fp8_fp8(bf[n][1], af[m][1], acc[mh * 4 + m][n], 0, 0, 0);
          }
      }
    }
    asm volatile("s_waitcnt vmcnt(0)" ::: "memory");
    __syncthreads();
  }
#undef G8_STAGE
}

DI void conv_tile_fp8(const float* __restrict__ src, int N, int ldsrc, u8* __restrict__ dst, int lddst,
                      int k0, int n0, float scale, int mode, char* smem) {
  const int tid = TIDX() & 255;
  float* t = (float*)smem + (TIDX() >> 8) * 4160;
  __syncthreads();
#pragma unroll
  for (int i = 0; i < 4; ++i) {
    const int k = (tid >> 4) + 16 * i, n = (tid & 15) * 4;
    float4 v = make_float4(0.f, 0.f, 0.f, 0.f);
    if (n0 + n < N) v = *(const float4*)(src + (size_t)(k0 + k) * ldsrc + n0 + n);
    float* d = t + k * 65 + n;
    d[0] = v.x * scale; d[1] = v.y * scale; d[2] = v.z * scale; d[3] = v.w * scale;
  }
  __syncthreads();
#pragma unroll
  for (int i = 0; i < 2; ++i) {
    const int pidx = tid + 256 * i, n = pidx >> 3, kc = (pidx & 7) * 8;
    u32x2 o;
    o[0] = pk4_fp8(t[(kc + 0) * 65 + n], t[(kc + 1) * 65 + n], t[(kc + 2) * 65 + n], t[(kc + 3) * 65 + n]);
    o[1] = pk4_fp8(t[(kc + 4) * 65 + n], t[(kc + 5) * 65 + n], t[(kc + 6) * 65 + n], t[(kc + 7) * 65 + n]);
    const int nn = n0 + n;
    const int row = (mode == 0) ? nn : ((nn >> 5) * 64 + (nn & 31) + (mode == 2 ? 32 : 0));
    *(u32x2*)(dst + (size_t)row * lddst + k0 + kc) = o;
  }
}

DI void conv_tile(const float* __restrict__ src, int N, int ldsrc, u16* __restrict__ dst, int lddst,
                  int k0, int n0, int mode, char* smem) {
  const int tid = TIDX() & 255;
  float* t = (float*)smem + (TIDX() >> 8) * 4160;
  __syncthreads();
#pragma unroll
  for (int i = 0; i < 4; ++i) {
    const int k = (tid >> 4) + 16 * i, n = (tid & 15) * 4;
    float4 v = make_float4(0.f, 0.f, 0.f, 0.f);
    if (n0 + n < N) v = *(const float4*)(src + (size_t)(k0 + k) * ldsrc + n0 + n);
    float* d = t + k * 65 + n;
    d[0] = v.x; d[1] = v.y; d[2] = v.z; d[3] = v.w;
  }
  __syncthreads();
#pragma unroll
  for (int i = 0; i < 2; ++i) {
    const int pidx = tid + 256 * i, n = pidx >> 3, kc = (pidx & 7) * 8;
    u32x4 o;
    o[0] = pk(t[(kc + 0) * 65 + n], t[(kc + 1) * 65 + n]);
    o[1] = pk(t[(kc + 2) * 65 + n], t[(kc + 3) * 65 + n]);
    o[2] = pk(t[(kc + 4) * 65 + n], t[(kc + 5) * 65 + n]);
    o[3] = pk(t[(kc + 6) * 65 + n], t[(kc + 7) * 65 + n]);
    const int nn = n0 + n;
    const int row = (mode == 0) ? nn : ((nn >> 5) * 64 + (nn & 31) + (mode == 2 ? 32 : 0));
    *(u32x4*)(dst + (size_t)row * lddst + k0 + kc) = o;
  }
}

DI void conv_matrix_items(const float* src, int K, int N, int Npad, u16* dst, int mode, int item, char* smem) {
  const int ntn = Npad >> 6;
  const int kt = item / ntn, nt = item % ntn;
  conv_tile(src, N, N, dst, K, kt * 64, nt * 64, mode, smem);
}

DI void conv_moe_layer(const Params& p, int layer, int item, char* smem) {
  item = 2 * item + (TIDX() >> 8);
  const int which = item / 5632, r = item % 5632;
  const int e = r / 352, tl = r % 352;
  u16* WGU = (u16*)(p.ws + OFF_WGU);
  u16* WDN = (u16*)(p.ws + OFF_WDN);
  const size_t eo = ((size_t)layer * 16 + e) * (size_t)(1024 * 1408);
  if (which == 0) {
    conv_tile_fp8(p.ec_w_gate + eo, 1408, 1408, (u8*)WGU + (size_t)e * 2816 * 1024, 1024, (tl / 22) * 64, (tl % 22) * 64, 64.0f, 1, smem);
  } else if (which == 1) {
    conv_tile_fp8(p.ec_w_up + eo, 1408, 1408, (u8*)WGU + (size_t)e * 2816 * 1024, 1024, (tl / 22) * 64, (tl % 22) * 64, 64.0f, 2, smem);
  } else {
    { const int kt_ = tl / 16, nt_ = tl % 16;
      conv_tile_fp8(p.ec_w_down + eo, 1024, 1024, (u8*)WDN + (size_t)e * 1024 * 1408, 1408, kt_ * 64, nt_ * 64, 128.0f, 0, smem); }
  }
}

DI void phase_prologue(const Params& p, char* smem) {
  const int npairs = (960 + 256 + 768 + 256) / 2;
  for (int pr = BIDX(); pr < npairs; pr += GDIM()) {
    const int item = 2 * pr + (TIDX() >> 8);
    if (item < 960) conv_matrix_items(p.even_w_in, 1024, 3600, 3840, (u16*)(p.ws + OFF_WIN), 0, item, smem);
    else if (item < 1216) conv_matrix_items(p.even_w_out, 1024, 1024, 1024, (u16*)(p.ws + OFF_WOE), 0, item - 960, smem);
    else if (item < 1984) conv_matrix_items(p.da_w_in, 1024, 3072, 3072, (u16*)(p.ws + OFF_WQKV), 0, item - 1216, smem);
    else conv_matrix_items(p.da_w_out, 1024, 1024, 1024, (u16*)(p.ws + OFF_WOO), 0, item - 1984, smem);
  }
  for (int item = BIDX(); item < 3 * 5632 / 2; item += GDIM()) conv_moe_layer(p, 0, item, smem);
  float2* rope = (float2*)(p.ws + OFF_ROPE);
  for (int i = BIDX() * NTHR + TIDX(); i < 2048 * 32; i += GDIM() * NTHR) {
    const int pos = i >> 5, d = i & 31;
    const float inv = powf(10000.0f, -(float)(2 * d) / 64.0f);
    const float ang = (float)pos * inv;
    const double a = (double)ang;
    const double kk = rint(a * 0.15915494309189535);
    const float r = (float)(a - kk * 6.283185307179586);
    rope[i] = make_float2(__cosf(r), __sinf(r));
  }
}

DI void phase_conv0(const Params& p, const GroupCtx& G, char* smem) {
  u16* XB = (u16*)(p.ws + OFF_R2);
  const size_t n8 = (size_t)G.T * 128;
  for (size_t i = (size_t)BIDX() * NTHR + TIDX(); i < n8; i += (size_t)GDIM() * NTHR) {
    const float4 a = *(const float4*)(G.xin + i * 8), b = *(const float4*)(G.xin + i * 8 + 4);
    u32x4 o; o[0] = pk(a.x, a.y); o[1] = pk(a.z, a.w); o[2] = pk(b.x, b.y); o[3] = pk(b.z, b.w);
    *(u32x4*)(XB + i * 8) = o;
  }
}

DI void phase_gemm_in0(const Params& p, const GroupCtx& G, char* smem) {
  const u16* XB = (const u16*)(p.ws + OFF_R2);
  const u16* W = (const u16*)(p.ws + OFF_WIN);
  u16* PROJ = (u16*)(p.ws + OFF_R1);
  float* GATES = (float*)(p.ws + OFF_GATES);
  const int lane = TIDX() & 63, wid = TIDX() >> 6, wr = wid >> 2, wc = wid & 3, fr = lane & 15, fq = lane >> 4;
  const int nitems = (G.T >> 8) * 15;
  for (int item = VBID(); item < nitems; item += GDIM()) {
    int mt, nt; tile_decode(item, 15, mt, nt);
    f32x4 acc[8][4];
    gemm_tile<false>(XB, 1024, nullptr, mt * 256, W, 1024, nt * 256, 1024, acc, smem);
#pragma unroll
    for (int m = 0; m < 8; ++m) {
      const size_t row = (size_t)mt * 256 + wr * 128 + m * 16 + fr;
#pragma unroll
      for (int n = 0; n < 4; ++n) {
        const int col = nt * 256 + wc * 64 + n * 16 + 4 * fq;
        if (col < 3584) {
          u32x2 o; o[0] = pk(acc[m][n][0], acc[m][n][1]); o[1] = pk(acc[m][n][2], acc[m][n][3]);
          *(u32x2*)(PROJ + row * 3584 + col) = o;
        } else if (col < 3600) {
          const int c = col - 3584;
          f32x4 o;
#pragma unroll
          for (int j = 0; j < 4; ++j) o[j] = acc[m][n][j] + p.ml_gate_bias[c + j];
          *(f32x4*)(GATES + row * 16 + c) = o;
        }
      }
    }
  }
}

DI void phase_gemm_in1(const Params& p, const GroupCtx& G, char* smem) {
  const u16* XB = G.xb1;
  const u16* W = (const u16*)(p.ws + OFF_WQKV);
  u16* QKV = (u16*)(p.ws + OFF_R1);
  const float* rope = (const float*)(p.ws + OFF_ROPE);
  const int lane = TIDX() & 63, wid = TIDX() >> 6, wr = wid >> 2, wc = wid & 3, fr = lane & 15, fq = lane >> 4;
  const int nitems = (G.T >> 8) * 12;
  for (int item = VBID(); item < nitems; item += GDIM()) {
    int mt, nt; tile_decode(item, 12, mt, nt);
    f32x4 acc[8][4];
    gemm_tile<false>(XB, 1024, nullptr, mt * 256, W, 1024, nt * 256, 1024, acc, smem);
    const int cbase = nt * 256 + wc * 64;
    const int sec = cbase >> 10;
#pragma unroll
    for (int m = 0; m < 8; ++m) {
      const size_t row = (size_t)mt * 256 + wr * 128 + m * 16 + fr;
      if (sec < 2) {
        const int pos = (int)(row & 2047);
        const float sc = (sec == 0) ? 0.125f : 1.0f;
#pragma unroll
        for (int n = 0; n < 2; ++n) {
          const int d = n * 16 + 4 * fq;
          const float* rp = rope + ((size_t)pos * 32 + d) * 2;
          const f32x4 cs0 = *(const f32x4*)rp, cs1 = *(const f32x4*)(rp + 4);
          const float c[4] = {cs0[0], cs0[2], cs1[0], cs1[2]};
          const float s[4] = {cs0[1], cs0[3], cs1[1], cs1[3]};
          f32x4 o1, o2;
#pragma unroll
          for (int j = 0; j < 4; ++j) {
            const float x1 = acc[m][n][j], x2 = acc[m][n + 2][j];
            o1[j] = (x1 * c[j] - x2 * s[j]) * sc;
            o2[j] = (x1 * s[j] + x2 * c[j]) * sc;
          }
          acc[m][n] = o1; acc[m][n + 2] = o2;
        }
      }
#pragma unroll
      for (int n = 0; n < 4; ++n) {
        const int col = cbase + n * 16 + 4 * fq;
        u32x2 o; o[0] = pk(acc[m][n][0], acc[m][n][1]); o[1] = pk(acc[m][n][2], acc[m][n][3]);
        *(u32x2*)(QKV + row * 3072 + col) = o;
      }
    }
  }
}

DI void phase_gemm_out(const Params& p, const GroupCtx& G, int layer, char* smem) {
  const u16* Y = (const u16*)(p.ws + OFF_R3);
  const u16* W = (const u16*)(p.ws + (layer == 0 ? OFF_WOE : OFF_WOO));
  u16* MIX = (u16*)(p.ws + OFF_R1);
  const int lane = TIDX() & 63, wid = TIDX() >> 6, wr = wid >> 2, wc = wid & 3, fr = lane & 15, fq = lane >> 4;
  const int nitems = (G.T >> 8) * 4;
  for (int item = VBID(); item < nitems; item += GDIM()) {
    int mt, nt; tile_decode(item, 4, mt, nt);
    f32x4 acc[8][4];
    gemm_tile<false>(Y, 1024, nullptr, mt * 256, W, 1024, nt * 256, 1024, acc, smem);
#pragma unroll
    for (int m = 0; m < 8; ++m) {
      const size_t row = (size_t)mt * 256 + wr * 128 + m * 16 + fr;
#pragma unroll
      for (int n = 0; n < 4; ++n) {
        const int col = nt * 256 + wc * 64 + n * 16 + 4 * fq;
        u32x2 o; o[0] = pk(acc[m][n][0], acc[m][n][1]); o[1] = pk(acc[m][n][2], acc[m][n][3]);
        *(u32x2*)(MIX + row * 1024 + col) = o;
      }
    }
  }
}

DI void phase_gemm_gu(const Params& p, const GroupCtx& G, char* smem) {
  const u8* X1 = (const u8*)(p.ws + OFF_X1Q);
  const u8* WGU = (const u8*)(p.ws + OFF_WGU);
  const int* IDX = (const int*)(p.ws + OFF_IDX);
  u8* H = (u8*)(p.ws + OFF_R1);
  const int MT = G.cap >> 8;
  const int nitems = 16 * MT * 11;
  for (int item = VBID(); item < nitems; item += GDIM()) {
    const int e = item / (MT * 11); int mt, nt; tile_decode(item - e * (MT * 11), 11, mt, nt);
    f32x4 acc[8][4];
    gemm_tile_fp8<true>(X1, 1024, IDX + e * G.cap, mt * 256, WGU + (size_t)e * 2816 * 1024, 1024, nt * 256, 1024, acc, smem);
    const int lane = TIDX() & 63, wid = TIDX() >> 6, wr = wid >> 2, wc = wid & 3, fr = lane & 15, fq = lane >> 4;
#pragma unroll
    for (int m = 0; m < 8; ++m) {
      const size_t row = (size_t)e * G.cap + mt * 256 + wr * 128 + m * 16 + fr;
#pragma unroll
      for (int n = 0; n < 2; ++n) {
        const int f = (nt * 4 + wc) * 32 + n * 16 + 4 * fq;
        float hv[4];
#pragma unroll
        for (int j = 0; j < 4; ++j) {
          const float g = acc[m][n][j] * (1.0f / 64.0f), u = acc[m][n + 2][j] * (1.0f / 64.0f);
          hv[j] = g / (1.0f + __expf(-g)) * u;
        }
        *(u32*)(H + row * 1408 + f) = pk4_fp8(hv[0], hv[1], hv[2], hv[3]);
      }
    }
  }
}

DI void phase_gemm_dn(const Params& p, const GroupCtx& G, u16* YE, char* smem) {
  const u8* H = (const u8*)(p.ws + OFF_R1);
  const u8* WDN = (const u8*)(p.ws + OFF_WDN);
  const float* GATE = (const float*)(p.ws + OFF_GATE);
  const int lane = TIDX() & 63, wid = TIDX() >> 6, wr = wid >> 2, wc = wid & 3, fr = lane & 15, fq = lane >> 4;
  const int MT = G.cap >> 8;
  const int nitems = 16 * MT * 4;
  for (int item = VBID(); item < nitems; item += GDIM()) {
    const int e = item / (MT * 4); int mt, nt; tile_decode(item - e * (MT * 4), 4, mt, nt);
    f32x4 acc[8][4];
    gemm_tile_fp8<false>(H + ((size_t)e * G.cap + mt * 256) * 1408, 1408, nullptr, 0, WDN + (size_t)e * 1024 * 1408, 1408, nt * 256, 1408, acc, smem);
#pragma unroll
    for (int m = 0; m < 8; ++m) {
      const size_t row = (size_t)e * G.cap + mt * 256 + wr * 128 + m * 16 + fr;
      const float gate = GATE[row] * (1.0f / 128.0f);
#pragma unroll
      for (int n = 0; n < 4; ++n) {
        const int col = nt * 256 + wc * 64 + n * 16 + 4 * fq;
        u32x2 o; o[0] = pk(acc[m][n][0] * gate, acc[m][n][1] * gate); o[1] = pk(acc[m][n][2] * gate, acc[m][n][3] * gate);
        *(u32x2*)(YE + row * 1024 + col) = o;
      }
    }
  }
}

struct NaCtx { int r, h, rs; size_t tokbase; };
DI NaCtx na_decode(int item) {
  NaCtx c; c.r = item & 31; c.h = (item >> 5) & 7; c.tokbase = (size_t)(item >> 8) * 2048;
  c.rs = min(max(c.r - 4, 0), 24);
  return c;
}
DI void na_loadV(const u16* P, const NaCtx& c, int tid, u32x4 (&R)[16]) {
#pragma unroll
  for (int k = 0; k < 16; ++k) {
    const int i = tid + 256 * k;
    const int key = i >> 3, pc = i & 7;
    R[k] = *(const u32x4*)(P + (c.tokbase + c.rs * 64 + key) * 3584 + 1024 + c.h * 64 + pc * 8);
  }
}

DI void na_phase(const Params& p, int n_pairs, char* smem0) {
  const int tid = TIDX() & 255, lane = tid & 63, wid = tid >> 6, fr = lane & 15, fq = lane >> 4;
  const int sub = TIDX() >> 8;
  char* smem = smem0 + sub * 75776;
  u16* sV = (u16*)smem;
  float* sR = (float*)(smem + 512 * 72 * 2);
  const u16* P = (const u16*)(p.ws + OFF_R1);
  u16* YM = (u16*)(p.ws + OFF_R3);
  const int gd = GDIM();
  const int cb = wid;
  const int bs = (cb == 0) ? 0 : (cb == 1) ? 8 : (cb == 2) ? 24 : 32;
  const int qc = cb * 16 + fr;
  const int wc0 = min(max(qc - 8, 0), 48);
  const unsigned vbase = (unsigned)(size_t)sV;
  const int q4 = (lane & 15) >> 2, p4 = lane & 3;
  int pair = VBID();
  u32x4 R[16];
  if (pair < n_pairs) { const NaCtx c0 = na_decode(2 * pair + sub); na_loadV(P, c0, tid, R); }
  while (pair < n_pairs) {
    const NaCtx c = na_decode(2 * pair + sub);
    const int r = c.r, h = c.h, rs = c.rs;
    const size_t qtok = c.tokbase + r * 64 + qc;
    bf16x8 qf[2];
    qf[0] = ld8(P + qtok * 3584 + h * 64 + fq * 8);
    qf[1] = ld8(P + qtok * 3584 + h * 64 + 32 + fq * 8);
    bf16x8 kfa[8][2];
#pragma unroll
    for (int f = 0; f < 8; ++f) {
      const int w = f >> 1, c0 = bs + (f & 1) * 16;
      const u16* kp = P + (c.tokbase + (rs + w) * 64 + c0 + fr) * 3584 + 512 + h * 64 + fq * 8;
      kfa[f][0] = ld8(kp); kfa[f][1] = ld8(kp + 32);
    }
    __syncthreads();
#pragma unroll
    for (int k = 0; k < 16; ++k) {
      const int i = tid + 256 * k;
      *(u32x4*)(sV + (i >> 3) * 72 + (i & 7) * 8) = R[k];
    }
    for (int i = tid; i < 465; i += 256) sR[i] = p.na_rpb[h * 465 + i];
    __syncthreads();
    const int next = pair + gd;
    bf16x8 kfb[8][2];
#pragma unroll
    for (int f = 0; f < 8; ++f) {
      const int w = 4 + (f >> 1), c0 = bs + (f & 1) * 16;
      const u16* kp = P + (c.tokbase + (rs + w) * 64 + c0 + fr) * 3584 + 512 + h * 64 + fq * 8;
      kfb[f][0] = ld8(kp); kfb[f][1] = ld8(kp + 32);
    }
    f32x4 s[16];
#pragma unroll
    for (int f = 0; f < 8; ++f) {
      f32x4 a = {0.f, 0.f, 0.f, 0.f};
      a = MFMA(kfa[f][0], qf[0], a);
      a = MFMA(kfa[f][1], qf[1], a);
      s[f] = a;
    }
#pragma unroll
    for (int f = 0; f < 8; ++f) {
      f32x4 a = {0.f, 0.f, 0.f, 0.f};
      a = MFMA(kfb[f][0], qf[0], a);
      a = MFMA(kfb[f][1], qf[1], a);
      s[8 + f] = a;
    }
    __builtin_amdgcn_sched_barrier(0);
    if (next < n_pairs) { const NaCtx cn = na_decode(2 * next + sub); na_loadV(P, cn, tid, R); }
    float mx = -INFINITY;
#pragma unroll
    for (int f = 0; f < 16; ++f) {
      const int w = f >> 1;
      const int dr = rs + w - r + 7;
#pragma unroll
      for (int j = 0; j < 4; ++j) {
        const int kc = bs + (f & 1) * 16 + 4 * fq + j;
        const bool valid = (kc >= wc0) && (kc < wc0 + 16);
        const int dc = min(max(kc - qc + 15, 0), 30);
        const float v = valid ? (s[f][j] * 0.125f + sR[dr * 31 + dc]) : -INFINITY;
        s[f][j] = v;
        mx = fmaxf(mx, v);
      }
    }
    mx = fmaxf(mx, __shfl_xor(mx, 16));
    mx = fmaxf(mx, __shfl_xor(mx, 32));
    float l = 0.f;
#pragma unroll
    for (int f = 0; f < 16; ++f)
#pragma unroll
      for (int j = 0; j < 4; ++j) {
        const float pv = __expf(s[f][j] - mx);
        s[f][j] = pv;
        l += pv;
      }
    l += __shfl_xor(l, 16);
    l += __shfl_xor(l, 32);
    f32x4 o[4];
#pragma unroll
    for (int cc = 0; cc < 4; ++cc) o[cc] = f32x4{0.f, 0.f, 0.f, 0.f};
#pragma unroll
    for (int w = 0; w < 8; ++w) {
      const bf16x8 pb = pack8(s[2 * w], s[2 * w + 1]);
      const int key0 = w * 64 + bs + 4 * fq + q4;
      bf16x8 va[4];
      tr_read_4x2(vbase + (unsigned)((key0 * 72 + 4 * p4) * 2), va);
#pragma unroll
      for (int cc = 0; cc < 4; ++cc) o[cc] = MFMA(va[cc], pb, o[cc]);
    }
    const float inv = 1.0f / l;
#pragma unroll
    for (int cc = 0; cc < 4; ++cc) {
      u32x2 ov; ov[0] = pk(o[cc][0] * inv, o[cc][1] * inv); ov[1] = pk(o[cc][2] * inv, o[cc][3] * inv);
      *(u32x2*)(YM + qtok * 1024 + h * 64 + 16 * cc + 4 * fq) = ov;
    }
    pair = next;
  }
}

DI float logsigmoidf(float x) { return fminf(x, 0.f) - log1pf(__expf(-fabsf(x))); }

DI void ml_item(const Params& p, const GroupCtx& G, int item, char* smem) {
  const int tid = TIDX(), lane = tid & 63, wid = tid >> 6, fr = lane & 15, fq = lane >> 4;
  const int eh = item & 1, dir = (item >> 1) & 1, h = (item >> 2) & 3, b = item >> 4;
  u16* sK = (u16*)smem;
  u16* sV = sK + 128 * 136;
  u16* sC = sV + 128 * 72;
  float* s_a = (float*)(sC + 80 * 136);
  float* s_M = s_a + 128;
  float* s_wi = s_a + 256;
  float* s_ws = s_a + 384;
  float* s_en = s_a + 512;
  float* s_sc = s_a + 640;
  const u16* P = (const u16*)(p.ws + OFF_R1);
  const float* GT = (const float*)(p.ws + OFF_GATES);
  u16* HOUT = (u16*)(p.ws + OFF_R4) + (size_t)dir * G.T * 512;
  const size_t tokbase = (size_t)b * 2048;
  const float kscale = 0.08838834764831845f;
  const unsigned kbase = (unsigned)(size_t)sK, vbase = (unsigned)(size_t)sV;
  const int q4 = (lane & 15) >> 2, p4 = lane & 3;
  const bf16x8 ones = {16256, 16256, 16256, 16256, 16256, 16256, 16256, 16256};
  f32x4 Cacc[5];
#pragma unroll
  for (int n = 0; n < 5; ++n) Cacc[n] = f32x4{0.f, 0.f, 0.f, 0.f};
  float mcarry = 0.f;
  u32x4 RK[4], RV[2];
  float gn[4] = {0.f, 0.f, 0.f, 0.f};
#define CTOK(cb_, tau) ((cb_) + (size_t)(dir ? 127 - (tau) : (tau)))
  auto prefetch = [&](size_t cb_) {
#pragma unroll
    for (int k = 0; k < 4; ++k) { const int i = tid + NTHR * k; RK[k] = *(const u32x4*)(P + CTOK(cb_, i >> 4) * 3584 + 2048 + h * 128 + (i & 15) * 8); }
#pragma unroll
    for (int k = 0; k < 2; ++k) { const int i = tid + NTHR * k; RV[k] = *(const u32x4*)(P + CTOK(cb_, i >> 3) * 3584 + 2560 + h * 128 + eh * 64 + (i & 7) * 8); }
    if (wid == 0) {
      gn[0] = GT[CTOK(cb_, 2 * lane) * 16 + dir * 4 + h];     gn[1] = GT[CTOK(cb_, 2 * lane + 1) * 16 + dir * 4 + h];
      gn[2] = GT[CTOK(cb_, 2 * lane) * 16 + 8 + dir * 4 + h]; gn[3] = GT[CTOK(cb_, 2 * lane + 1) * 16 + 8 + dir * 4 + h];
    }
  };
  prefetch(tokbase + (size_t)(dir ? 15 : 0) * 128);
  for (int cc = 0; cc < 16; ++cc) {
    const int chunk = dir ? 15 - cc : cc;
    const size_t cbase = tokbase + (size_t)chunk * 128;
#define TOK(tau) (cbase + (size_t)(dir ? 127 - (tau) : (tau)))
    __syncthreads();
#pragma unroll
    for (int k = 0; k < 4; ++k) { const int i = tid + NTHR * k; *(u32x4*)(sK + (i >> 4) * 136 + (i & 15) * 8) = RK[k]; }
#pragma unroll
    for (int k = 0; k < 2; ++k) { const int i = tid + NTHR * k; *(u32x4*)(sV + (i >> 3) * 72 + (i & 7) * 8) = RV[k]; }
    bf16x8 qf[4];
    {
      const u16* qp = P + TOK(16 * wid + fr) * 3584 + 1536 + h * 128 + fq * 8;
#pragma unroll
      for (int ks = 0; ks < 4; ++ks) qf[ks] = ld8(qp + ks * 32);
    }
#pragma unroll
    for (int n = 0; n < 5; ++n) {
      u32x2 o; o[0] = pk(Cacc[n][0], Cacc[n][1]); o[1] = pk(Cacc[n][2], Cacc[n][3]);
      *(u32x2*)(sC + (16 * n + fr) * 136 + 16 * wid + 4 * fq) = o;
    }
    if (wid == 0) {
      const int t0 = 2 * lane, t1 = 2 * lane + 1;
      const float ig0 = gn[0], ig1 = gn[1];
      const float lf0 = logsigmoidf(gn[2]);
      const float lf1 = logsigmoidf(gn[3]);
      const float ps = lf0 + lf1;
      float sc = ps;
#pragma unroll
      for (int o = 1; o < 64; o <<= 1) { const float t = __shfl_up(sc, o); if (lane >= o) sc += t; }
      const float excl = sc - ps;
      const float b0 = excl + lf0, b1 = sc;
      const float a0 = ig0 - b0, a1 = ig1 - b1;
      float sm = fmaxf(a0, a1);
#pragma unroll
      for (int o = 1; o < 64; o <<= 1) { const float t = __shfl_up(sm, o); if (lane >= o) sm = fmaxf(sm, t); }
      float exm = __shfl_up(sm, 1);
      if (lane == 0) exm = -INFINITY;
      const float pm0 = fmaxf(exm, a0), pm1 = sm;
      const float M0 = fmaxf(mcarry, pm0), M1 = fmaxf(mcarry, pm1);
      const float blast = __shfl(sc, 63), M127 = __shfl(M1, 63);
      s_a[t0] = a0; s_a[t1] = a1;
      s_M[t0] = M0; s_M[t1] = M1;
      s_wi[t0] = __expf(mcarry - M0); s_wi[t1] = __expf(mcarry - M1);
      s_en[t0] = __expf(-(b0 + M0)); s_en[t1] = __expf(-(b1 + M1));
      s_ws[t0] = __expf(a0 - M127) * kscale; s_ws[t1] = __expf(a1 - M127) * kscale;
      if (lane == 0) { s_sc[0] = __expf(mcarry - M127); s_sc[1] = blast + M127; }
    }
    __syncthreads();
    const float decay = s_sc[0];
    mcarry = s_sc[1];
    if (cc + 1 < 16) prefetch(tokbase + (size_t)(dir ? 14 - cc : cc + 1) * 128);
    {
      const int tb = wid;
      const int tl = 16 * tb + fr;
      f32x4 acc[5];
      const f32x4 wi = *(const f32x4*)(s_wi + 16 * tb + 4 * fq);
#pragma unroll
      for (int n = 0; n < 5; ++n) {
        f32x4 a = {0.f, 0.f, 0.f, 0.f};
#pragma unroll
        for (int ks = 0; ks < 4; ++ks) a = MFMA(qf[ks], ld8(sC + (16 * n + fr) * 136 + 32 * ks + 8 * fq), a);
#pragma unroll
        for (int j = 0; j < 4; ++j) a[j] *= wi[j];
        acc[n] = a;
      }
      const float Mt = s_M[tl];
      const int npair = (tb >> 1) + 1;
#pragma unroll 1
      for (int i = 0; i < npair; ++i) {
        f32x4 sf[2];
#pragma unroll
        for (int u = 0; u < 2; ++u) {
          const int sb = 2 * i + u;
          f32x4 a = {0.f, 0.f, 0.f, 0.f};
          if (sb <= tb) {
#pragma unroll
            for (int ks = 0; ks < 4; ++ks) a = MFMA(ld8(sK + (16 * sb + fr) * 136 + 32 * ks + 8 * fq), qf[ks], a);
          }
          const f32x4 av = *(const f32x4*)(s_a + 16 * sb + 4 * fq);
#pragma unroll
          for (int j = 0; j < 4; ++j) {
            const int si = 16 * sb + 4 * fq + j;
            a[j] = (si <= tl) ? a[j] * kscale * __expf(av[j] - Mt) : 0.f;
          }
          sf[u] = a;
        }
        const bf16x8 pa = pack8(sf[0], sf[1]);
        const int row0 = 32 * i + 4 * fq + q4;
#pragma unroll
        for (int n = 0; n < 4; ++n) {
          const unsigned a0 = vbase + (unsigned)((row0 * 72 + 16 * n + 4 * p4) * 2);
          acc[n] = MFMA(pa, tr_read2(a0, a0 + 16 * 72 * 2), acc[n]);
        }
        acc[4] = MFMA(pa, ones, acc[4]);
      }
      const f32x4 en = *(const f32x4*)(s_en + 16 * tb + 4 * fq);
#pragma unroll
      for (int j = 0; j < 4; ++j) {
        const int t = 16 * tb + 4 * fq + j;
        const float inv = 1.0f / fmaxf(fabsf(acc[4][j]), en[j]);
        u16* hp = HOUT + TOK(t) * 512 + h * 128 + eh * 64 + fr;
#pragma unroll
        for (int n = 0; n < 4; ++n) hp[16 * n] = (u16)(pk(acc[n][j] * inv, 0.f) & 0xffffu);
      }
    }
    __syncthreads();
    for (int i = tid; i < 128 * 16; i += NTHR) {
      const int tau = i >> 4, pc = i & 15;
      const float w = s_ws[tau];
      u32x4 v = *(u32x4*)(sK + tau * 136 + pc * 8);
#pragma unroll
      for (int k = 0; k < 4; ++k) v[k] = pk(bflo(v[k]) * w, bfhi(v[k]) * w);
      *(u32x4*)(sK + tau * 136 + pc * 8) = v;
    }
    __syncthreads();
#pragma unroll
    for (int n = 0; n < 5; ++n)
#pragma unroll
      for (int j = 0; j < 4; ++j) Cacc[n][j] *= decay;
#pragma unroll
    for (int ks = 0; ks < 4; ++ks) {
      const int row0 = 32 * ks + 4 * fq + q4;
      const unsigned ak = kbase + (unsigned)((row0 * 136 + 16 * wid + 4 * p4) * 2);
      const bf16x8 ka = tr_read2(ak, ak + 16 * 136 * 2);
#pragma unroll
      for (int n = 0; n < 5; ++n) {
        bf16x8 bv = ones;
        if (n < 4) {
          const unsigned a0 = vbase + (unsigned)((row0 * 72 + 16 * n + 4 * p4) * 2);
          bv = tr_read2(a0, a0 + 16 * 72 * 2);
        }
        Cacc[n] = MFMA(ka, bv, Cacc[n]);
      }
    }
#undef TOK
  }
#undef CTOK
}

DI void phase_mix0(const Params& p, const GroupCtx& G, char* smem) {
  const int n_ml = G.NB * 16;
  for (int item = VBID(); item < n_ml; item += GDIM()) ml_item(p, G, item, smem);
  na_phase(p, G.NB * 128, smem);
}

DI void phase_comb0(const Params& p, const GroupCtx& G) {
  const int lane = TIDX() & 63, wid = TIDX() >> 6;
  const u16* HF = (const u16*)(p.ws + OFF_R4);
  const u16* HB = HF + (size_t)G.T * 512;
  const u16* P = (const u16*)(p.ws + OFF_R1);
  u16* YM = (u16*)(p.ws + OFF_R3);
  const int col = (lane >> 4) * 128 + (lane & 15) * 8;
  for (int t = BIDX() * NWAV + wid; t < G.T; t += GDIM() * NWAV) {
    const u32x4 a = *(const u32x4*)(HF + (size_t)t * 512 + col), b = *(const u32x4*)(HB + (size_t)t * 512 + col);
    float x[8];
#pragma unroll
    for (int k = 0; k < 4; ++k) { x[2 * k] = bflo(a[k]) + bflo(b[k]); x[2 * k + 1] = bfhi(a[k]) + bfhi(b[k]); }
    float s = 0.f;
#pragma unroll
    for (int k = 0; k < 8; ++k) s += x[k];
#pragma unroll
    for (int o = 8; o >= 1; o >>= 1) s += __shfl_xor(s, o);
    const float mean = s * (1.0f / 128.0f);
    float v = 0.f;
#pragma unroll
    for (int k = 0; k < 8; ++k) { const float d = x[k] - mean; v += d * d; }
#pragma unroll
    for (int o = 8; o >= 1; o >>= 1) v += __shfl_xor(v, o);
    const float rstd = rsqrtf(v * (1.0f / 128.0f) + LN_EPS_F);
    const u32x4 ob = *(const u32x4*)(P + (size_t)t * 3584 + 3072 + col);
    float y[8];
#pragma unroll
    for (int k = 0; k < 8; ++k) {
      const float o = (k & 1) ? bfhi(ob[k >> 1]) : bflo(ob[k >> 1]);
      const float sg = 1.0f / (1.0f + __expf(-o));
      y[k] = sg * (x[k] - mean) * rstd * p.ml_norm_g[col + k];
    }
    u32x4 ov; ov[0] = pk(y[0], y[1]); ov[1] = pk(y[2], y[3]); ov[2] = pk(y[4], y[5]); ov[3] = pk(y[6], y[7]);
    *(u32x4*)(YM + (size_t)t * 1024 + 512 + col) = ov;
  }
}

constexpr size_t OFF_LSE = OFF_R1 + 402653184;

DI u16* da_partial(const Params& p, const GroupCtx& G, int br) {
  return br == 0 ? (u16*)(p.ws + OFF_R4) : (br == 1 ? G.p1 : (u16*)(p.ws + OFF_R3));
}

struct DaCtx { int br, g, sh, n, i0, h; size_t tokbase; };
DI DaCtx da_decode(int item) {
  DaCtx c;
  const int sub = item % 48, bh = item / 48;
  c.h = bh & 15;
  c.tokbase = (size_t)(bh >> 4) * 2048;
  int blk;
  if (sub < 16) { c.br = 0; c.g = 0; blk = sub; }
  else if (sub < 32) { c.br = 1; c.g = (sub - 16) >> 2; blk = (sub - 16) & 3; }
  else { c.br = 2; c.g = sub - 32; blk = 0; }
  c.sh = 2 * c.br; c.n = 2048 >> c.sh; c.i0 = blk * 128;
  return c;
}
DI void da_load(const u16* P, const DaCtx& c, int tid, int lane, int wid, u32x4 (&R)[9], bf16x8 (&Q)[2]) {
#pragma unroll
  for (int k = 0; k < 9; ++k) {
    const int i = tid + NTHR * k;
    const int kl = min(i >> 4, 271), pc = i & 15;
    const int u = min(max(c.i0 - 64 + kl, 0), c.n - 1);
    R[k] = *(const u32x4*)(P + (c.tokbase + ((size_t)u << c.sh) + c.g) * 3072 + 1024 + c.h * 64 + (pc >> 3) * 1024 + (pc & 7) * 8);
  }
  const int uq = c.i0 + 16 * wid + (lane & 15);
  const u16* qp = P + (c.tokbase + ((size_t)uq << c.sh) + c.g) * 3072 + c.h * 64 + (lane >> 4) * 8;
  Q[0] = ld8(qp); Q[1] = ld8(qp + 32);
}
DI void da_store(char* smem, int tid, const u32x4 (&R)[9]) {
  u16* sK = (u16*)smem;
  u16* sV = sK + 272 * 72;
#pragma unroll
  for (int k = 0; k < 9; ++k) {
    const int i = tid + NTHR * k;
    if (i < 272 * 16) {
      const int kl = i >> 4, pc = i & 15;
      *(u32x4*)((pc >> 3 ? sV : sK) + kl * 72 + (pc & 7) * 8) = R[k];
    }
  }
}
DI void da_compute(const Params& p, const GroupCtx& G, const DaCtx& c, const bf16x8 (&qf)[2], char* smem) {
  const int tid = TIDX(), lane = tid & 63, wid = tid >> 6, fr = lane & 15, fq = lane >> 4;
  const int br = c.br, g = c.g, sh = c.sh, n = c.n, i0 = c.i0, h = c.h;
  u16* sK = (u16*)smem;
  u16* sV = sK + 272 * 72;
  u16* PO = da_partial(p, G, br);
  float* LSE = (float*)(p.ws + OFF_LSE) + (size_t)br * G.T * 16;
  const int uq = i0 + 16 * wid + fr;
  const size_t qtok = c.tokbase + ((size_t)uq << sh) + g;
  f32x4 s[10];
  float mx = -INFINITY;
  const bool edge = (i0 - 64 + 16 * wid < 0) || (i0 - 64 + 16 * wid + 144 > n);
#pragma unroll
  for (int f = 0; f < 9; ++f) {
    const u16* kp = sK + (16 * wid + 16 * f + fr) * 72 + fq * 8;
    f32x4 a = {0.f, 0.f, 0.f, 0.f};
    a = MFMA(ld8(kp), qf[0], a);
    a = MFMA(ld8(kp + 32), qf[1], a);
    if (f == 0 || f == 8) {
#pragma unroll
      for (int j = 0; j < 4; ++j) {
        const int d = 16 * f - 64 + 4 * fq + j - fr;
        const bool valid = (f == 0) ? (d >= -64) : (d <= 64);
        a[j] = valid ? a[j] : -INFINITY;
      }
    }
    if (edge) {
#pragma unroll
      for (int j = 0; j < 4; ++j) {
        const int u = i0 - 64 + 16 * wid + 16 * f + 4 * fq + j;
        a[j] = ((u >= 0) && (u < n)) ? a[j] : -INFINITY;
      }
    }
#pragma unroll
    for (int j = 0; j < 4; ++j) mx = fmaxf(mx, a[j]);
    s[f] = a;
  }
  mx = fmaxf(mx, __shfl_xor(mx, 16));
  mx = fmaxf(mx, __shfl_xor(mx, 32));
  float l = 0.f;
#pragma unroll
  for (int f = 0; f < 9; ++f)
#pragma unroll
    for (int j = 0; j < 4; ++j) {
      const float pv = __expf(s[f][j] - mx);
      s[f][j] = pv;
      l += pv;
    }
  s[9] = f32x4{0.f, 0.f, 0.f, 0.f};
  l += __shfl_xor(l, 16);
  l += __shfl_xor(l, 32);
  f32x4 o[4];
#pragma unroll
  for (int cc = 0; cc < 4; ++cc) o[cc] = f32x4{0.f, 0.f, 0.f, 0.f};
  const unsigned vbase = (unsigned)(size_t)sV;
  const int q4 = (lane & 15) >> 2, p4 = lane & 3;
#pragma unroll
  for (int kk = 0; kk < 5; ++kk) {
    const bf16x8 pb = pack8(s[2 * kk], s[2 * kk + 1]);
    bf16x8 va[4];
    tr_read_4x2(vbase + (unsigned)((((16 * wid + 32 * kk + 4 * fq + q4) * 72) + 4 * p4) * 2), va);
#pragma unroll
    for (int cc = 0; cc < 4; ++cc) o[cc] = MFMA(va[cc], pb, o[cc]);
  }
  const float inv = 1.0f / l;
#pragma unroll
  for (int cc = 0; cc < 4; ++cc) {
    u32x2 ov; ov[0] = pk(o[cc][0] * inv, o[cc][1] * inv); ov[1] = pk(o[cc][2] * inv, o[cc][3] * inv);
    *(u32x2*)(PO + qtok * 1024 + h * 64 + 16 * cc + 4 * fq) = ov;
  }
  if (fq == 0) LSE[qtok * 16 + h] = mx + __logf(l);
}

DI void phase_mix1(const Params& p, const GroupCtx& G, char* smem) {
  const int tid = TIDX(), lane = tid & 63, wid = tid >> 6;
  const u16* P = (const u16*)(p.ws + OFF_R1);
  const int nitems = G.NB * 16 * 48;
  const int gd = GDIM();
  int item = VBID();
  u32x4 R[9];
  bf16x8 qn[2];
  DaCtx cn = da_decode(item < nitems ? item : 0);
  if (item < nitems) da_load(P, cn, tid, lane, wid, R, qn);
  while (item < nitems) {
    const DaCtx cc = cn;
    bf16x8 qc[2];
    qc[0] = qn[0]; qc[1] = qn[1];
    __syncthreads();
    da_store(smem, tid, R);
    __syncthreads();
    const int next = item + gd;
    if (next < nitems) { cn = da_decode(next); da_load(P, cn, tid, lane, wid, R, qn); }
    da_compute(p, G, cc, qc, smem);
    item = next;
  }
}

DI void phase_comb1(const Params& p, const GroupCtx& G) {
  const int lane = TIDX() & 63, wid = TIDX() >> 6;
  const u16* P0 = da_partial(p, G, 0);
  const u16* P1 = da_partial(p, G, 1);
  u16* P2 = da_partial(p, G, 2);
  const float* LSE = (const float*)(p.ws + OFF_LSE);
  const int hd = lane >> 2;
  for (int t = BIDX() * NWAV + wid; t < G.T; t += GDIM() * NWAV) {
    const float l0 = LSE[(size_t)t * 16 + hd], l1 = LSE[((size_t)G.T + t) * 16 + hd], l2 = LSE[((size_t)2 * G.T + t) * 16 + hd];
    const float mm = fmaxf(l0, fmaxf(l1, l2));
    const float e0 = __expf(l0 - mm), e1 = __expf(l1 - mm), e2 = __expf(l2 - mm);
    const float is = 1.0f / (e0 + e1 + e2);
    const float w0 = e0 * is, w1 = e1 * is, w2 = e2 * is;
#pragma unroll
    for (int hh = 0; hh < 2; ++hh) {
      const size_t off = (size_t)t * 1024 + lane * 16 + hh * 8;
      const u32x4 a = *(const u32x4*)(P0 + off), bb = *(const u32x4*)(P1 + off), c = *(const u32x4*)(P2 + off);
      u32x4 ov;
#pragma unroll
      for (int k = 0; k < 4; ++k)
        ov[k] = pk(w0 * bflo(a[k]) + w1 * bflo(bb[k]) + w2 * bflo(c[k]), w0 * bfhi(a[k]) + w1 * bfhi(bb[k]) + w2 * bfhi(c[k]));
      *(u32x4*)(P2 + off) = ov;
    }
  }
}

DI void phase_ln1(const Params& p, const GroupCtx& G, int layer, char* smem) {
  const int tid = TIDX(), lane = tid & 63, wid = tid >> 6;
  float* wT = (float*)smem;
  const float* wr = p.ec_router + (size_t)layer * 16384;
  __syncthreads();
  for (int i = tid; i < 16384; i += NTHR) wT[(i & 15) * 1024 + (i >> 4)] = wr[i];
  __syncthreads();
  const u16* MIX = (const u16*)(p.ws + OFF_R1);
  const u16* XB = G.xb1;
  u16* X1 = (u16*)(p.ws + OFF_R4);
  float* AFF = (float*)(p.ws + OFF_AFF);
  const float* gam = p.ln_mix_g + layer * 1024;
  const float* bet = p.ln_mix_b + layer * 1024;
  u32x4 nmx[2];
  f32x4 nxf[4];
  u32x4 nxb[2];
  auto ld_tok = [&](int t) {
#pragma unroll
    for (int hh = 0; hh < 2; ++hh) {
      const int c = hh * 512 + lane * 8;
      nmx[hh] = *(const u32x4*)(MIX + (size_t)t * 1024 + c);
      if (layer == 0) {
        nxf[2 * hh] = *(const f32x4*)(G.xin + (size_t)t * 1024 + c);
        nxf[2 * hh + 1] = *(const f32x4*)(G.xin + (size_t)t * 1024 + c + 4);
      } else {
        nxb[hh] = *(const u32x4*)(XB + (size_t)t * 1024 + c);
      }
    }
  };
  const int tstride = GDIM() * NWAV;
  int t = BIDX() * NWAV + wid;
  if (t < G.T) ld_tok(t);
  for (; t < G.T; t += tstride) {
    float v[16];
#pragma unroll
    for (int hh = 0; hh < 2; ++hh) {
      float xi[8];
      if (layer == 0) {
#pragma unroll
        for (int k = 0; k < 4; ++k) { xi[k] = nxf[2 * hh][k]; xi[4 + k] = nxf[2 * hh + 1][k]; }
      } else {
#pragma unroll
        for (int k = 0; k < 4; ++k) { xi[2 * k] = bflo(nxb[hh][k]); xi[2 * k + 1] = bfhi(nxb[hh][k]); }
      }
#pragma unroll
      for (int k = 0; k < 4; ++k) {
        v[hh * 8 + 2 * k] = DN_ALPHA_F * xi[2 * k] + bflo(nmx[hh][k]);
        v[hh * 8 + 2 * k + 1] = DN_ALPHA_F * xi[2 * k + 1] + bfhi(nmx[hh][k]);
      }
    }
    if (t + tstride < G.T) ld_tok(t + tstride);
    float s = 0.f;
#pragma unroll
    for (int k = 0; k < 16; ++k) s += v[k];
    const float mean = wave_sum(s) * (1.0f / 1024.0f);
    float q = 0.f;
#pragma unroll
    for (int k = 0; k < 16; ++k) { const float d = v[k] - mean; q += d * d; }
    const float rstd = rsqrtf(wave_sum(q) * (1.0f / 1024.0f) + LN_EPS_F);
#pragma unroll
    for (int hh = 0; hh < 2; ++hh) {
      const int c = hh * 512 + lane * 8;
      const float4 g0 = *(const float4*)(gam + c), g1 = *(const float4*)(gam + c + 4);
      const float4 b0 = *(const float4*)(bet + c), b1 = *(const float4*)(bet + c + 4);
      const float gg[8] = {g0.x, g0.y, g0.z, g0.w, g1.x, g1.y, g1.z, g1.w};
      const float bb[8] = {b0.x, b0.y, b0.z, b0.w, b1.x, b1.y, b1.z, b1.w};
#pragma unroll
      for (int k = 0; k < 8; ++k) v[hh * 8 + k] = (v[hh * 8 + k] - mean) * rstd * gg[k] + bb[k];
      u32x4 ov; ov[0] = pk(v[hh * 8 + 0], v[hh * 8 + 1]); ov[1] = pk(v[hh * 8 + 2], v[hh * 8 + 3]);
      ov[2] = pk(v[hh * 8 + 4], v[hh * 8 + 5]); ov[3] = pk(v[hh * 8 + 6], v[hh * 8 + 7]);
      *(u32x4*)(X1 + (size_t)t * 1024 + c) = ov;
      u32x2 oq; oq[0] = pk4_fp8(v[hh * 8 + 0], v[hh * 8 + 1], v[hh * 8 + 2], v[hh * 8 + 3]); oq[1] = pk4_fp8(v[hh * 8 + 4], v[hh * 8 + 5], v[hh * 8 + 6], v[hh * 8 + 7]);
      *(u32x2*)((u8*)(p.ws + OFF_X1Q) + (size_t)t * 1024 + c) = oq;
    }
    float d16[16];
#pragma unroll
    for (int e = 0; e < 16; ++e) {
      float d = 0.f;
#pragma unroll
      for (int hh = 0; hh < 2; ++hh) {
        const float* wp = wT + e * 1024 + hh * 512 + lane * 8;
        const f32x4 w0 = *(const f32x4*)wp, w1 = *(const f32x4*)(wp + 4);
#pragma unroll
        for (int k = 0; k < 4; ++k) { d += v[hh * 8 + k] * w0[k]; d += v[hh * 8 + 4 + k] * w1[k]; }
      }
      d16[e] = d;
      if ((e & 3) == 3) __builtin_amdgcn_sched_barrier(0);
    }
    float d8[8];
    {
      const bool hi = (lane & 8) != 0;
#pragma unroll
      for (int k = 0; k < 8; ++k) {
        const float keep = hi ? d16[8 + k] : d16[k];
        const float send = hi ? d16[k] : d16[8 + k];
        d8[k] = keep + __shfl_xor(send, 8);
      }
    }
    float d4[4];
    {
      const bool hi = (lane & 4) != 0;
#pragma unroll
      for (int k = 0; k < 4; ++k) {
        const float keep = hi ? d8[4 + k] : d8[k];
        const float send = hi ? d8[k] : d8[4 + k];
        d4[k] = keep + __shfl_xor(send, 4);
      }
    }
    float d2[2];
    {
      const bool hi = (lane & 2) != 0;
#pragma unroll
      for (int k = 0; k < 2; ++k) {
        const float keep = hi ? d4[2 + k] : d4[k];
        const float send = hi ? d4[k] : d4[2 + k];
        d2[k] = keep + __shfl_xor(send, 2);
      }
    }
    float mylogit;
    {
      const bool hi = (lane & 1) != 0;
      const float keep = hi ? d2[1] : d2[0];
      const float send = hi ? d2[0] : d2[1];
      mylogit = keep + __shfl_xor(send, 1);
    }
    mylogit += __shfl_xor(mylogit, 16);
    mylogit += __shfl_xor(mylogit, 32);
    float mx = mylogit;
#pragma unroll
    for (int o = 8; o >= 1; o >>= 1) mx = fmaxf(mx, __shfl_xor(mx, o));
    const float ex = __expf(mylogit - mx);
    float se = ex;
#pragma unroll
    for (int o = 8; o >= 1; o >>= 1) se += __shfl_xor(se, o);
    if (lane < 16) AFF[(size_t)lane * G.T + t] = ex / se;
  }
}

DI void phase_sel(const Params& p, const GroupCtx& G, char* smem) {
  if (BIDX() >= 16) return;
  const int tid = TIDX(), lane = tid & 63, wid = tid >> 6;
  const int e = BIDX(), T = G.T, cap = G.cap;
  const u32* a = (const u32*)(p.ws + OFF_AFF) + (size_t)e * T;
  int* IDX = (int*)(p.ws + OFF_IDX) + e * cap;
  float* GATE = (float*)(p.ws + OFF_GATE) + e * cap;
  int* SEL = (int*)(p.ws + OFF_SEL);
  int* red = (int*)smem;
  int* scn = red + 16;
  const int per = T >> 9;
  const int tbeg = tid * per;
  u32 v[128];
#pragma unroll
  for (int i = 0; i < 32; ++i) {
    u32x4 x = {0u, 0u, 0u, 0u};
    if (i * 4 < per) x = *(const u32x4*)(a + tbeg + i * 4);
    v[4 * i] = x[0]; v[4 * i + 1] = x[1]; v[4 * i + 2] = x[2]; v[4 * i + 3] = x[3];
  }
  __syncthreads();
  u32 lo = 0u, hi = 0x3F800001u;
  int it = 0;
  while (hi - lo > 1u) {
    const u32 mid = lo + ((hi - lo) >> 1);
    int c = 0;
#pragma unroll
    for (int i = 0; i < 128; ++i) c += (v[i] >= mid) ? 1 : 0;
#pragma unroll
    for (int o = 32; o >= 1; o >>= 1) c += __shfl_xor(c, o);
    const int par = it & 1;
    if (lane == 0) red[par * 8 + wid] = c;
    __syncthreads();
    int tot = 0;
#pragma unroll
    for (int w = 0; w < NWAV; ++w) tot += red[par * 8 + w];
    if (tot >= cap) lo = mid; else hi = mid;
    ++it;
  }
  const u32 thr = lo;
  int my_gt = 0, my_eq = 0;
#pragma unroll
  for (int i = 0; i < 128; ++i) { my_gt += (v[i] > thr) ? 1 : 0; my_eq += (v[i] == thr) ? 1 : 0; }
  int sg = my_gt, se = my_eq;
#pragma unroll
  for (int o = 1; o < 64; o <<= 1) {
    const int tg = __shfl_up(sg, o), te = __shfl_up(se, o);
    if (lane >= o) { sg += tg; se += te; }
  }
  __syncthreads();
  if (lane == 63) { scn[wid * 2] = sg; scn[wid * 2 + 1] = se; }
  __syncthreads();
  int base_gt = sg - my_gt, base_eq = se - my_eq, cnt_gt = 0;
#pragma unroll
  for (int w = 0; w < NWAV; ++w) {
    const int g_ = scn[w * 2], e_ = scn[w * 2 + 1];
    if (w < wid) { base_gt += g_; base_eq += e_; }
    cnt_gt += g_;
  }
  const int need = cap - cnt_gt;
#pragma unroll 1
  for (int i0 = 0; i0 < per; i0 += 16) {
    u32 w[16];
#pragma unroll
    for (int k = 0; k < 4; ++k) {
      const u32x4 x = *(const u32x4*)(a + tbeg + i0 + 4 * k);
      w[4 * k] = x[0]; w[4 * k + 1] = x[1]; w[4 * k + 2] = x[2]; w[4 * k + 3] = x[3];
    }
    int sl[16];
#pragma unroll
    for (int k = 0; k < 16; ++k) {
      const u32 u = w[k];
      int slot = -1;
      if (u > thr) slot = base_gt++;
      else if (u == thr) { const int r = base_eq++; if (r < need) slot = cnt_gt + r; }
      sl[k] = slot;
    }
#pragma unroll
    for (int k = 0; k < 16; ++k) {
      const int t = tbeg + i0 + k;
      if (sl[k] >= 0) { IDX[sl[k]] = t; GATE[sl[k]] = __uint_as_float(w[k]); }
      SEL[(size_t)t * 16 + e] = sl[k];
    }
  }
}

DI void phase_ln2(const Params& p, const GroupCtx& G, int layer, const u16* YE) {
  const int lane = TIDX() & 63, wid = TIDX() >> 6;
  const u16* X1 = (const u16*)(p.ws + OFF_R4);
  const int* SEL = (const int*)(p.ws + OFF_SEL);
  u16* XB = G.xb1;
  const float* gam = p.ln_ffn_g + layer * 1024;
  const float* bet = p.ln_ffn_b + layer * 1024;
  u32x4 nx1[2];
  int nsel = -1;
  auto ld_tok = [&](int t) {
    nx1[0] = *(const u32x4*)(X1 + (size_t)t * 1024 + lane * 8);
    nx1[1] = *(const u32x4*)(X1 + (size_t)t * 1024 + 512 + lane * 8);
    nsel = SEL[(size_t)t * 16 + (lane & 15)];
  };
  const int tstride = GDIM() * NWAV;
  int t = BIDX() * NWAV + wid;
  if (t < G.T) ld_tok(t);
  for (; t < G.T; t += tstride) {
    float v[16];
#pragma unroll
    for (int hh = 0; hh < 2; ++hh)
#pragma unroll
      for (int k = 0; k < 4; ++k) { v[hh * 8 + 2 * k] = DN_ALPHA_F * bflo(nx1[hh][k]); v[hh * 8 + 2 * k + 1] = DN_ALPHA_F * bfhi(nx1[hh][k]); }
    const int selv = nsel;
    if (t + tstride < G.T) ld_tok(t + tstride);
    unsigned msk = (unsigned)(__ballot(selv >= 0) & 0xffffull);
    while (msk) {
      int ee[4];
      u32x4 y[4][2];
#pragma unroll
      for (int k = 0; k < 4; ++k) {
        ee[k] = msk ? (__ffs(msk) - 1) : -1;
        if (msk) msk &= msk - 1;
      }
#pragma unroll
      for (int k = 0; k < 4; ++k) {
        if (ee[k] >= 0) {
          const int s = __shfl(selv, ee[k]);
          const u16* yp = YE + ((size_t)ee[k] * G.cap + s) * 1024;
          y[k][0] = *(const u32x4*)(yp + lane * 8);
          y[k][1] = *(const u32x4*)(yp + 512 + lane * 8);
        } else {
          y[k][0] = u32x4{0u, 0u, 0u, 0u}; y[k][1] = u32x4{0u, 0u, 0u, 0u};
        }
      }
#pragma unroll
      for (int k = 0; k < 4; ++k)
#pragma unroll
        for (int hh = 0; hh < 2; ++hh)
#pragma unroll
          for (int j = 0; j < 4; ++j) { v[hh * 8 + 2 * j] += bflo(y[k][hh][j]); v[hh * 8 + 2 * j + 1] += bfhi(y[k][hh][j]); }
    }
    float s = 0.f;
#pragma unroll
    for (int k = 0; k < 16; ++k) s += v[k];
    const float mean = wave_sum(s) * (1.0f / 1024.0f);
    float q = 0.f;
#pragma unroll
    for (int k = 0; k < 16; ++k) { const float d = v[k] - mean; q += d * d; }
    const float rstd = rsqrtf(wave_sum(q) * (1.0f / 1024.0f) + LN_EPS_F);
#pragma unroll
    for (int hh = 0; hh < 2; ++hh) {
      const int c = hh * 512 + lane * 8;
      const float4 g0 = *(const float4*)(gam + c), g1 = *(const float4*)(gam + c + 4);
      const float4 b0 = *(const float4*)(bet + c), b1 = *(const float4*)(bet + c + 4);
      const float gg[8] = {g0.x, g0.y, g0.z, g0.w, g1.x, g1.y, g1.z, g1.w};
      const float bb[8] = {b0.x, b0.y, b0.z, b0.w, b1.x, b1.y, b1.z, b1.w};
      float y[8];
#pragma unroll
      for (int k = 0; k < 8; ++k) y[k] = (v[hh * 8 + k] - mean) * rstd * gg[k] + bb[k];
      if (layer == 0) {
        u32x4 ov; ov[0] = pk(y[0], y[1]); ov[1] = pk(y[2], y[3]); ov[2] = pk(y[4], y[5]); ov[3] = pk(y[6], y[7]);
        *(u32x4*)(XB + (size_t)t * 1024 + c) = ov;
      } else {
        float* op = G.out + (size_t)t * 1024 + c;
        *(float4*)op = make_float4(y[0], y[1], y[2], y[3]);
        *(float4*)(op + 4) = make_float4(y[4], y[5], y[6], y[7]);
      }
    }
  }
}


#define XB_TMO      128
#define XB_XCNT(j)  (256  + 64 * (j))
#define XB_XSUB(j)  (1280 + 64 * (j))
#define XB_XGEN(j)  (2304 + 64 * (j))
#define XB_TOP      3328
#define XB_TOPGEN   3392
#define XCD_BAR_WORDS 3456
#define XB_SPIN_CAP (1u << 22)
DI unsigned xb_ld(unsigned* p)              { return __hip_atomic_load(p, __ATOMIC_RELAXED, __HIP_MEMORY_SCOPE_AGENT); }
DI unsigned xb_add(unsigned* p, unsigned v) { return __hip_atomic_fetch_add(p, v, __ATOMIC_RELAXED, __HIP_MEMORY_SCOPE_AGENT); }
DI unsigned xb_xcc_id() { return (unsigned)__builtin_amdgcn_s_getreg((3 << 11) | 20) & 0xFu; }
#define XB_SPIN(cond, bar) do { unsigned _sp = 0; while (cond) { __builtin_amdgcn_s_sleep(1); \
    if ((++_sp & 255u) == 0u) { if (xb_ld(&(bar)[XB_TMO])) break; if (_sp > XB_SPIN_CAP) { atomicAdd(&(bar)[XB_TMO], 1u); break; } } } } while (0)
struct XcdBarrier { unsigned* bar; unsigned x; volatile LAS unsigned* st; };
DI XcdBarrier xcd_barrier_post(unsigned* bar, volatile LAS unsigned* st) {
  XcdBarrier b; b.bar = bar; b.x = xb_xcc_id(); b.st = st;
  if (threadIdx.x == 0) (void)xb_add(&bar[XB_XCNT(b.x)], 1u);
  return b;
}
DI void xcd_barrier_complete(unsigned* bar, unsigned x, unsigned& nloc, unsigned& nx) {
  const unsigned G = gridDim.x * gridDim.y * gridDim.z;
  unsigned sum, cnt, mine, sp = 0u;
  for (;;) {
    sum = 0u; cnt = 0u; mine = 0u;
#pragma unroll
    for (unsigned j = 0; j < 16; ++j) { const unsigned c = xb_ld(&bar[XB_XCNT(j)]); sum += c; cnt += (c > 0u) ? 1u : 0u; mine = (j == x) ? c : mine; }
    if (sum == G) break;
    __builtin_amdgcn_s_sleep(1);
    if ((++sp & 255u) == 0u) { if (xb_ld(&bar[XB_TMO])) break; if (sp > XB_SPIN_CAP) { atomicAdd(&bar[XB_TMO], 1u); break; } }
  }
  nloc = mine > 0u ? mine : 1u; nx = cnt > 0u ? cnt : 1u;
}
DI void xcd_barrier(const XcdBarrier& b) {
  asm volatile("s_waitcnt vmcnt(0)" ::: "memory");
  __syncthreads();
  if (threadIdx.x == 0) {
    unsigned* bar = b.bar;
    __builtin_amdgcn_s_waitcnt(0);
    unsigned nloc = b.st[0], nx = b.st[1];
    if (nloc == 0u) { xcd_barrier_complete(bar, b.x, nloc, nx); b.st[0] = nloc; b.st[1] = nx; }
    const unsigned old = xb_add(&bar[XB_XSUB(b.x)], 1u);
    const unsigned gen = old / nloc;
    if (old + 1u == (gen + 1u) * nloc) {
      __builtin_amdgcn_fence(__ATOMIC_RELEASE, "agent");
      asm volatile("s_waitcnt vmcnt(0)" ::: "memory");
      const unsigned og = xb_add(&bar[XB_TOP], 1u);
      const unsigned tg = og / nx;
      if (og + 1u == (tg + 1u) * nx) xb_add(&bar[XB_TOPGEN], 1u);
      else XB_SPIN(xb_ld(&bar[XB_TOPGEN]) == tg, bar);
      __builtin_amdgcn_fence(__ATOMIC_ACQUIRE, "agent");
      xb_add(&bar[XB_XGEN(b.x)], 1u);
      asm volatile("s_waitcnt vmcnt(0)" ::: "memory");
    } else {
      XB_SPIN(xb_ld(&bar[XB_XGEN(b.x)]) == gen, bar);
      __builtin_amdgcn_fence(__ATOMIC_ACQUIRE, "agent");
      asm volatile("s_waitcnt vmcnt(0)" ::: "memory");
    }
  }
  __syncthreads();
}

DI void run_phase(const Params& p, int ph, char* smem) {
  if (ph == 0) { phase_prologue(p, smem); return; }
  int seg, s;
  if (ph <= 20) { seg = (ph - 1) / 10; s = (ph - 1) % 10; }
  else { seg = 2 + (ph - 21) / 9; s = 10 + (ph - 21) % 9; }
  const int g = seg & 1;
  GroupCtx G;
  float* out_p = p.out;
  float* out_s = p.out + (size_t)32768 * 1024;
  if (g == 0) { G.T = 32768; G.NB = 16; G.cap = 4096; G.xin = p.x_prompt; G.out = out_p; }
  else { G.T = 65536; G.NB = 32; G.cap = 8192; G.xin = p.x_sample; G.out = out_s; }
  G.xb1 = (g == 0) ? (u16*)out_p : (u16*)(p.ws + OFF_R2);
  G.p1 = (g == 0) ? ((u16*)out_p + (size_t)32768 * 1024) : (u16*)out_s;
  u16* YE0 = (u16*)out_s;
  u16* YE1 = (g == 0) ? (u16*)(p.ws + OFF_R3) : (u16*)(p.ws + OFF_R2);
  switch (s) {
    case 0: phase_conv0(p, G, smem); break;
    case 1: phase_gemm_in0(p, G, smem); break;
    case 2: phase_mix0(p, G, smem); break;
    case 3: phase_comb0(p, G); break;
    case 4: phase_gemm_out(p, G, 0, smem); break;
    case 5: phase_ln1(p, G, 0, smem); break;
    case 6: phase_sel(p, G, smem); break;
    case 7: phase_gemm_gu(p, G, smem); break;
    case 8: phase_gemm_dn(p, G, YE0, smem); break;
    case 9:
      phase_ln2(p, G, 0, YE0);
      if (g == 1) { for (int item = BIDX(); item < 3 * 5632 / 2; item += GDIM()) conv_moe_layer(p, 1, item, smem); }
      break;
    case 10: phase_gemm_in1(p, G, smem); break;
    case 11: phase_mix1(p, G, smem); break;
    case 12: phase_comb1(p, G); break;
    case 13: phase_gemm_out(p, G, 1, smem); break;
    case 14: phase_ln1(p, G, 1, smem); break;
    case 15: phase_sel(p, G, smem); break;
    case 16: phase_gemm_gu(p, G, smem); break;
    case 17: phase_gemm_dn(p, G, YE1, smem); break;
    case 18: phase_ln2(p, G, 1, YE1); break;
    default: break;
  }
}

#ifndef REPEAT_MASK
#define REPEAT_MASK 0
#endif
#ifndef DBG_STOP
#define DBG_STOP 0
#endif
#ifndef DBG_OFF
#define DBG_OFF OFF_R4
#endif
__global__ void __launch_bounds__(256, 2) dbg_dump(Params p) {
  const u16* src = (const u16*)(p.ws + DBG_OFF);
  const size_t n = (size_t)98304 * 1024, nsrc = (size_t)32768 * 1024;
  for (size_t i = (size_t)blockIdx.x * 256 + threadIdx.x; i < n; i += (size_t)gridDim.x * 256)
  {
    float v = (i < nsrc) ? __uint_as_float(((u32)src[i]) << 16) : 0.f;
    if (v != v) v = 1.0e6f; else if (fabsf(v) > 1.0e30f) v = 3.0e6f;
    p.out[i] = v;
  }
}
__global__ void __launch_bounds__(512) hybrid_mega(Params p, int ph_lo, int ph_hi) {
  extern __shared__ __attribute__((aligned(16))) char smem[];
  volatile LAS unsigned* xst = (volatile LAS unsigned*)((LAS char*)smem + (SMEM_BYTES - 16));
  if (threadIdx.x == 0) { xst[0] = 0u; xst[1] = 0u; }
  __syncthreads();
  const XcdBarrier xb = xcd_barrier_post((unsigned*)(p.ws + OFF_BAR), xst);
#pragma unroll 1
  for (int ph = ph_lo; ph < ph_hi; ++ph) {
    Params q = p;
#define LAUNDER(f) asm volatile("" : "+s"(q.f))
    LAUNDER(x_prompt); LAUNDER(x_sample); LAUNDER(even_w_in); LAUNDER(ml_gate_bias); LAUNDER(na_rpb); LAUNDER(ml_norm_g);
    LAUNDER(even_w_out); LAUNDER(da_w_in); LAUNDER(da_w_out); LAUNDER(ln_mix_g); LAUNDER(ln_mix_b); LAUNDER(ec_router);
    LAUNDER(ec_w_gate); LAUNDER(ec_w_up); LAUNDER(ec_w_down); LAUNDER(ln_ffn_g); LAUNDER(ln_ffn_b); LAUNDER(out); LAUNDER(ws);
#undef LAUNDER
    int reps = 1;
#if REPEAT_MASK
    if (ph > 0 && ((REPEAT_MASK >> (ph % 32)) & 1)) reps = 2;
#endif
#pragma unroll 1
    for (int rr = 0; rr < reps; ++rr) {
      if (rr) xcd_barrier(xb);
      run_phase(q, ph, smem);
    }
    if (ph + 1 < ph_hi) { if (ph_lo < 0) cg::this_grid().sync(); else xcd_barrier(xb); }
  }
}

extern "C" void kernel_launch(void* const* d_in, const int* in_sizes, int n_in, void* d_out, int out_size,
                              void* d_ws, size_t ws_size, hipStream_t stream) {
  (void)in_sizes; (void)n_in; (void)out_size;
  Params p;
  memset(&p, 0, sizeof(p));
  p.x_prompt = (const float*)d_in[0];   p.x_sample = (const float*)d_in[1];
  p.even_w_in = (const float*)d_in[2];  p.ml_gate_bias = (const float*)d_in[3];
  p.na_rpb = (const float*)d_in[4];     p.ml_norm_g = (const float*)d_in[5];
  p.even_w_out = (const float*)d_in[6]; p.da_w_in = (const float*)d_in[7];
  p.da_w_out = (const float*)d_in[8];   p.ln_mix_g = (const float*)d_in[9];
  p.ln_mix_b = (const float*)d_in[10];  p.ec_router = (const float*)d_in[11];
  p.ec_w_gate = (const float*)d_in[12]; p.ec_w_up = (const float*)d_in[13];
  p.ec_w_down = (const float*)d_in[14]; p.ln_ffn_g = (const float*)d_in[15];
  p.ln_ffn_b = (const float*)d_in[16];
  p.out = (float*)d_out;
  p.ws = (char*)d_ws;
  if (ws_size < WS_NEEDED) { fprintf(stderr, "workspace too small: %zu < %zu\n", ws_size, (size_t)WS_NEEDED); return; }
  static int grid_blocks = 0;
  if (!grid_blocks) {
    int dev = 0, cus = 0, per_cu = 0;
    hipGetDevice(&dev);
    hipDeviceGetAttribute(&cus, hipDeviceAttributeMultiprocessorCount, dev);
    hipFuncSetAttribute((const void*)hybrid_mega, hipFuncAttributeMaxDynamicSharedMemorySize, SMEM_BYTES);
    hipOccupancyMaxActiveBlocksPerMultiprocessor(&per_cu, hybrid_mega, NTHR, SMEM_BYTES);
    if (per_cu < 1) per_cu = 1;
    if (per_cu > 1) per_cu = 1;
    grid_blocks = cus * per_cu;
  }
  hipMemsetAsync((char*)d_ws + OFF_BAR, 0, XCD_BAR_WORDS * 4, stream);
#if MULTI_LAUNCH
  for (int ph = 0; ph < (DBG_STOP ? DBG_STOP : NPHASES); ++ph) {
    hipLaunchKernelGGL(hybrid_mega, dim3(grid_blocks), dim3(NTHR), SMEM_BYTES, stream, p, ph, ph + 1);
  }
  if (DBG_STOP) hipLaunchKernelGGL(dbg_dump, dim3(grid_blocks), dim3(256), 0, stream, p);
#else
  int lo = 0, hi = NPHASES;
  void* args[] = {&p, &lo, &hi};
  hipError_t e = hipLaunchCooperativeKernel((void*)hybrid_mega, dim3(grid_blocks), dim3(NTHR), args, SMEM_BYTES, stream);
  if (e != hipSuccess) fprintf(stderr, "cooperative launch failed: %s (grid %d)\n", hipGetErrorString(e), grid_blocks);
#endif
}
```

```cpp
#include <hip/hip_runtime.h>
#include <hip/hip_cooperative_groups.h>
#include <cstdio>
#include <cstring>
namespace cg = cooperative_groups;

#ifndef MULTI_LAUNCH
#define MULTI_LAUNCH 0
#endif

typedef unsigned short u16;
typedef unsigned int u32;
using bf16x8 = __attribute__((ext_vector_type(8))) short;
using s16x4 = __attribute__((ext_vector_type(4))) short;
using f32x4 = __attribute__((ext_vector_type(4))) float;
using u32x4 = __attribute__((ext_vector_type(4))) unsigned;
using u32x2 = __attribute__((ext_vector_type(2))) unsigned;

#define DI __device__ __forceinline__
#define MFMA(a, b, c) __builtin_amdgcn_mfma_f32_16x16x32_bf16((a), (b), (c), 0, 0, 0)

constexpr int NPH_G = 19;
constexpr int NPHASES = 1 + 2 * 10 + 2 * 9;
constexpr int SMEM_BYTES = 155648;
constexpr int NTHR = 512;
constexpr int NWAV = 8;
#define LAS __attribute__((address_space(3)))
constexpr float DN_ALPHA_F = 1.41421356237309515f;
constexpr float LN_EPS_F = 1e-5f;

constexpr size_t OFF_WIN = 0;
constexpr size_t OFF_WOE = OFF_WIN + 7864320;
constexpr size_t OFF_WQKV = OFF_WOE + 2097152;
constexpr size_t OFF_WOO = OFF_WQKV + 6291456;
constexpr size_t OFF_ROPE = OFF_WOO + 2097152;
constexpr size_t OFF_WGU = OFF_ROPE + 524288;
constexpr size_t OFF_WDN = OFF_WGU + 92274688;
constexpr size_t OFF_AFF = OFF_WDN + 46137344;
constexpr size_t OFF_IDX = OFF_AFF + 4194304;
constexpr size_t OFF_GATE = OFF_IDX + 524288;
constexpr size_t OFF_SEL = OFF_GATE + 524288;
constexpr size_t OFF_GATES = OFF_SEL + 4194304;
constexpr size_t OFF_R1 = OFF_GATES + 4194304;
constexpr size_t OFF_X1Q = OFF_R1 + 201326592;
constexpr size_t OFF_R2 = OFF_R1 + 469762048;
constexpr size_t OFF_R3 = OFF_R2 + 134217728;
constexpr size_t OFF_R4 = OFF_R3 + 134217728;
constexpr size_t OFF_BAR = OFF_R4 + 134217728;
constexpr size_t WS_NEEDED = OFF_BAR + 16384;

struct Params {
  const float *x_prompt, *x_sample, *even_w_in, *ml_gate_bias, *na_rpb, *ml_norm_g, *even_w_out, *da_w_in, *da_w_out;
  const float *ln_mix_g, *ln_mix_b, *ec_router, *ec_w_gate, *ec_w_up, *ec_w_down, *ln_ffn_g, *ln_ffn_b;
  float* out;
  char* ws;
};

struct GroupCtx {
  int T, NB, cap;
  const float* xin;
  float* out;
  u16* xb1;
  u16* p1;
};

DI int TIDX() { int t = threadIdx.x; asm volatile("" : "+v"(t)); return t; }
DI int BIDX() { int t = blockIdx.x; asm volatile("" : "+s"(t)); return t; }
DI int GDIM() { int t = gridDim.x; asm volatile("" : "+s"(t)); return t; }
typedef float f32x2_t __attribute__((ext_vector_type(2)));
typedef __bf16 bf16x2_t __attribute__((ext_vector_type(2)));
DI u32 pk(float lo, float hi) { f32x2_t v = {lo, hi}; bf16x2_t b = __builtin_convertvector(v, bf16x2_t); return __builtin_bit_cast(u32, b); }
DI float bflo(u32 w) { return __uint_as_float(w << 16); }
DI float bfhi(u32 w) { return __uint_as_float(w & 0xffff0000u); }
DI bf16x8 ld8(const u16* p) { return *reinterpret_cast<const bf16x8*>(p); }
DI bf16x8 tr_read2(unsigned a0, unsigned a1) {
  s16x4 x, y;
  asm volatile("ds_read_b64_tr_b16 %0, %2\n\tds_read_b64_tr_b16 %1, %3\n\ts_waitcnt lgkmcnt(0)"
               : "=&v"(x), "=&v"(y) : "v"(a0), "v"(a1) : "memory");
  return __builtin_shufflevector(x, y, 0, 1, 2, 3, 4, 5, 6, 7);
}
DI void tr_read_4x2(unsigned base, bf16x8 (&out)[4]) {
  s16x4 x0, y0, x1, y1, x2, y2, x3, y3;
  asm volatile("ds_read_b64_tr_b16 %0, %8\n\t"
               "ds_read_b64_tr_b16 %1, %8 offset:2304\n\t"
               "ds_read_b64_tr_b16 %2, %8 offset:32\n\t"
               "ds_read_b64_tr_b16 %3, %8 offset:2336\n\t"
               "ds_read_b64_tr_b16 %4, %8 offset:64\n\t"
               "ds_read_b64_tr_b16 %5, %8 offset:2368\n\t"
               "ds_read_b64_tr_b16 %6, %8 offset:96\n\t"
               "ds_read_b64_tr_b16 %7, %8 offset:2400\n\t"
               "s_waitcnt lgkmcnt(0)"
               : "=&v"(x0), "=&v"(y0), "=&v"(x1), "=&v"(y1), "=&v"(x2), "=&v"(y2), "=&v"(x3), "=&v"(y3)
               : "v"(base) : "memory");
  out[0] = __builtin_shufflevector(x0, y0, 0, 1, 2, 3, 4, 5, 6, 7);
  out[1] = __builtin_shufflevector(x1, y1, 0, 1, 2, 3, 4, 5, 6, 7);
  out[2] = __builtin_shufflevector(x2, y2, 0, 1, 2, 3, 4, 5, 6, 7);
  out[3] = __builtin_shufflevector(x3, y3, 0, 1, 2, 3, 4, 5, 6, 7);
}
DI bf16x8 pack8(f32x4 a, f32x4 b) {
  u32x4 r; r[0] = pk(a[0], a[1]); r[1] = pk(a[2], a[3]); r[2] = pk(b[0], b[1]); r[3] = pk(b[2], b[3]);
  return __builtin_bit_cast(bf16x8, r);
}
DI float wave_sum(float v) {
#pragma unroll
  for (int o = 32; o >= 1; o >>= 1) v += __shfl_xor(v, o);
  return v;
}

DI int VBID() { const int b = BIDX(), g = GDIM(); return (g & 7) ? b : (b & 7) * (g >> 3) + (b >> 3); }
DI void tile_decode(int item, int NT, int& mt, int& nt) { const int mg = item / (NT * 8), rem = item - mg * (NT * 8); nt = rem >> 3; mt = mg * 8 + (rem & 7); }

template <bool GATHER>
DI void gemm_tile(const u16* __restrict__ A, int lda, const int* __restrict__ ridx, int row0,
                  const u16* __restrict__ Bt, int ldb, int col0, int K, f32x4 (&acc)[8][4], char* smem) {
  const int tid = TIDX(), lane = tid & 63, wid = tid >> 6, wr = wid >> 2, wc = wid & 3, fr = lane & 15, fq = lane >> 4;
  const int r0 = tid >> 3, pc = tid & 7;
  const int c = pc ^ ((r0 >> 1) & 7);
  unsigned pa[4];
#pragma unroll
  for (int i = 0; i < 4; ++i) {
    const int r = r0 + 64 * i;
    if (GATHER) pa[i] = (unsigned)ridx[row0 + r] * (unsigned)lda + c * 8;
    else pa[i] = (unsigned)(row0 + r) * (unsigned)lda + c * 8;
  }
  const u16* pb0 = Bt + (size_t)(col0 + r0) * ldb + c * 8;
  const size_t sb64 = (size_t)64 * ldb;
#pragma unroll
  for (int m = 0; m < 8; ++m)
#pragma unroll
    for (int n = 0; n < 4; ++n) acc[m][n] = f32x4{0.f, 0.f, 0.f, 0.f};
  const int key = (fr >> 1) & 7;
  const int p0 = (fq ^ key) * 16, p1 = ((fq ^ key) ^ 4) * 16;
  const char* rA = smem + (wr * 128 + fr) * 128;
  const char* rB = smem + 65536 + (wc * 64 + fr) * 128;
  LAS char* lds = (LAS char*)smem;
  const int wofs = tid * 16;
  const int nk = K >> 6;
#define G_STAGE(buf_, kt_) { const int ko_ = (kt_) * 64; _Pragma("unroll") for (int i = 0; i < 4; ++i) { \
      __builtin_amdgcn_global_load_lds((const unsigned*)(A + (size_t)pa[i] + ko_), (LAS unsigned*)(lds + (buf_) * 32768 + wofs + i * 8192), 16, 0, 0); \
      __builtin_amdgcn_global_load_lds((const unsigned*)(pb0 + i * sb64 + ko_), (LAS unsigned*)(lds + 65536 + (buf_) * 32768 + wofs + i * 8192), 16, 0, 0); } }
  __syncthreads();
  G_STAGE(0, 0);
  asm volatile("s_waitcnt vmcnt(0)" ::: "memory");
  __syncthreads();
  for (int kt = 0; kt < nk; ++kt) {
    const int cur = kt & 1;
    if (kt + 1 < nk) G_STAGE(cur ^ 1, kt + 1);
    const char* cA = rA + cur * 32768;
    const char* cB = rB + cur * 32768;
#pragma unroll
    for (int ks = 0; ks < 2; ++ks) {
      const int po = ks ? p1 : p0;
      bf16x8 bf[4];
#pragma unroll
      for (int n = 0; n < 4; ++n) bf[n] = *(const bf16x8*)(cB + n * 2048 + po);
#pragma unroll
      for (int mh = 0; mh < 2; ++mh) {
        bf16x8 af[4];
#pragma unroll
        for (int m = 0; m < 4; ++m) af[m] = *(const bf16x8*)(cA + (mh * 4 + m) * 2048 + po);
#pragma unroll
        for (int m = 0; m < 4; ++m)
#pragma unroll
          for (int n = 0; n < 4; ++n) acc[mh * 4 + m][n] = MFMA(bf[n], af[m], acc[mh * 4 + m][n]);
      }
    }
    asm volatile("s_waitcnt vmcnt(0)" ::: "memory");
    __syncthreads();
  }
#undef G_STAGE
}

typedef unsigned char u8;
DI u32 pk4_fp8(float a, float b, float c, float d) {
  int w = __builtin_amdgcn_cvt_pk_fp8_f32(a, b, 0, false);
  w = __builtin_amdgcn_cvt_pk_fp8_f32(c, d, w, true);
  return (u32)w;
}
template <bool GATHER>
DI void gemm_tile_fp8(const u8* __restrict__ A, int lda, const int* __restrict__ ridx, int row0, const u8* __restrict__ Bt, int ldb, int col0, int K,
                      f32x4 (&acc)[8][4], char* smem) {
  const int tid = TIDX(), lane = tid & 63, wid = tid >> 6, wr = wid >> 2, wc = wid & 3, fr = lane & 15, fq = lane >> 4;
  const int r0 = tid >> 3, pc = tid & 7;
  const int c = pc ^ ((r0 >> 1) & 7);
  unsigned pa[4];
#pragma unroll
  for (int i = 0; i < 4; ++i) pa[i] = (GATHER ? (unsigned)ridx[row0 + r0 + 64 * i] : (unsigned)(row0 + r0 + 64 * i)) * (unsigned)lda + c * 16;
  const u8* pb0 = Bt + (size_t)(col0 + r0) * ldb + c * 16;
  const size_t sb64 = (size_t)64 * ldb;
#pragma unroll
  for (int m = 0; m < 8; ++m)
#pragma unroll
    for (int n = 0; n < 4; ++n) acc[m][n] = f32x4{0.f, 0.f, 0.f, 0.f};
  const int key = (fr >> 1) & 7;
  const char* rA = smem + (wr * 128 + fr) * 128;
  const char* rB = smem + 65536 + (wc * 64 + fr) * 128;
  LAS char* lds = (LAS char*)smem;
  const int wofs = tid * 16;
  const int nk = K >> 7;
#define G8_STAGE(buf_, kt_) { const int ko_ = (kt_) * 128; _Pragma("unroll") for (int i = 0; i < 4; ++i) { \
      __builtin_amdgcn_global_load_lds((const unsigned*)(A + (size_t)pa[i] + ko_), (LAS unsigned*)(lds + (buf_) * 32768 + wofs + i * 8192), 16, 0, 0); \
      __builtin_amdgcn_global_load_lds((const unsigned*)(pb0 + i * sb64 + ko_), (LAS unsigned*)(lds + 65536 + (buf_) * 32768 + wofs + i * 8192), 16, 0, 0); } }
  __syncthreads();
  G8_STAGE(0, 0);
  asm volatile("s_waitcnt vmcnt(0)" ::: "memory");
  __syncthreads();
  for (int kt = 0; kt < nk; ++kt) {
    const int cur = kt & 1;
    if (kt + 1 < nk) G8_STAGE(cur ^ 1, kt + 1);
    const char* cA = rA + cur * 32768;
    const char* cB = rB + cur * 32768;
    typedef long long2_t __attribute__((ext_vector_type(2)));
#pragma unroll
    for (int jp = 0; jp < 2; ++jp) {
      const int po = ((4 * jp + fq) ^ key) * 16;
      long2_t bf[4];
#pragma unroll
      for (int n = 0; n < 4; ++n) bf[n] = *(const long2_t*)(cB + n * 2048 + po);
#pragma unroll
      for (int mh = 0; mh < 2; ++mh) {
        long2_t af[4];
#pragma unroll
        for (int m = 0; m < 4; ++m) af[m] = *(const long2_t*)(cA + (mh * 4 + m) * 2048 + po);
#pragma unroll
        for (int m = 0; m < 4; ++m)
#pragma unroll
          for (int n = 0; n < 4; ++n) {
            acc[mh * 4 + m][n] = __builtin_amdgcn_mfma_f32_16x16x32_fp8_fp8(bf[n][0], af[m][0], acc[mh * 4 + m][n], 0, 0, 0);
            acc[mh * 4 + m][n] = __builtin_amdgcn_mfma_f32_16x16x32_fp8_fp8(bf[n][1], af[m][1], acc[mh * 4 + m][n], 0, 0, 0);
          }
      }
    }
    asm volatile("s_waitcnt vmcnt(0)" ::: "memory");
    __syncthreads();
  }
#undef G8_STAGE
}

DI void conv_tile_fp8(const float* __restrict__ src, int N, int ldsrc, u8* __restrict__ dst, int lddst,
                      int k0, int n0, float scale, int mode, char* smem) {
  const int tid = TIDX() & 255;
  float* t = (float*)smem + (TIDX() >> 8) * 4160;
  __syncthreads();
#pragma unroll
  for (int i = 0; i < 4; ++i) {
    const int k = (tid >> 4) + 16 * i, n = (tid & 15) * 4;
    float4 v = make_float4(0.f, 0.f, 0.f, 0.f);
    if (n0 + n < N) v = *(const float4*)(src + (size_t)(k0 + k) * ldsrc + n0 + n);
    float* d = t + k * 65 + n;
    d[0] = v.x * scale; d[1] = v.y * scale; d[2] = v.z * scale; d[3] = v.w * scale;
  }
  __syncthreads();
#pragma unroll
  for (int i = 0; i < 2; ++i) {
    const int pidx = tid + 256 * i, n = pidx >> 3, kc = (pidx & 7) * 8;
    u32x2 o;
    o[0] = pk4_fp8(t[(kc + 0) * 65 + n], t[(kc + 1) * 65 + n], t[(kc + 2) * 65 + n], t[(kc + 3) * 65 + n]);
    o[1] = pk4_fp8(t[(kc + 4) * 65 + n], t[(kc + 5) * 65 + n], t[(kc + 6) * 65 + n], t[(kc + 7) * 65 + n]);
    const int nn = n0 + n;
    const int row = (mode == 0) ? nn : ((nn >> 5) * 64 + (nn & 31) + (mode == 2 ? 32 : 0));
    *(u32x2*)(dst + (size_t)row * lddst + k0 + kc) = o;
  }
}

DI void conv_tile(const float* __restrict__ src, int N, int ldsrc, u16* __restrict__ dst, int lddst,
                  int k0, int n0, int mode, char* smem) {
  const int tid = TIDX() & 255;
  float* t = (float*)smem + (TIDX() >> 8) * 4160;
  __syncthreads();
#pragma unroll
  for (int i = 0; i < 4; ++i) {
    const int k = (tid >> 4) + 16 * i, n = (tid & 15) * 4;
    float4 v = make_float4(0.f, 0.f, 0.f, 0.f);
    if (n0 + n < N) v = *(const float4*)(src + (size_t)(k0 + k) * ldsrc + n0 + n);
    float* d = t + k * 65 + n;
    d[0] = v.x; d[1] = v.y; d[2] = v.z; d[3] = v.w;
  }
  __syncthreads();
#pragma unroll
  for (int i = 0; i < 2; ++i) {
    const int pidx = tid + 256 * i, n = pidx >> 3, kc = (pidx & 7) * 8;
    u32x4 o;
    o[0] = pk(t[(kc + 0) * 65 + n], t[(kc + 1) * 65 + n]);
    o[1] = pk(t[(kc + 2) * 65 + n], t[(kc + 3) * 65 + n]);
    o[2] = pk(t[(kc + 4) * 65 + n], t[(kc + 5) * 65 + n]);
    o[3] = pk(t[(kc + 6) * 65 + n], t[(kc + 7) * 65 + n]);
    const int nn = n0 + n;
    const int row = (mode == 0) ? nn : ((nn >> 5) * 64 + (nn & 31) + (mode == 2 ? 32 : 0));
    *(u32x4*)(dst + (size_t)row * lddst + k0 + kc) = o;
  }
}

DI void conv_matrix_items(const float* src, int K, int N, int Npad, u16* dst, int mode, int item, char* smem) {
  const int ntn = Npad >> 6;
  const int kt = item / ntn, nt = item % ntn;
  conv_tile(src, N, N, dst, K, kt * 64, nt * 64, mode, smem);
}

DI void conv_moe_layer(const Params& p, int layer, int item, char* smem) {
  item = 2 * item + (TIDX() >> 8);
  const int which = item / 5632, r = item % 5632;
  const int e = r / 352, tl = r % 352;
  u16* WGU = (u16*)(p.ws + OFF_WGU);
  u16* WDN = (u16*)(p.ws + OFF_WDN);
  const size_t eo = ((size_t)layer * 16 + e) * (size_t)(1024 * 1408);
  if (which == 0) {
    conv_tile_fp8(p.ec_w_gate + eo, 1408, 1408, (u8*)WGU + (size_t)e * 2816 * 1024, 1024, (tl / 22) * 64, (tl % 22) * 64, 64.0f, 1, smem);
  } else if (which == 1) {
    conv_tile_fp8(p.ec_w_up + eo, 1408, 1408, (u8*)WGU + (size_t)e * 2816 * 1024, 1024, (tl / 22) * 64, (tl % 22) * 64, 64.0f, 2, smem);
  } else {
    { const int kt_ = tl / 16, nt_ = tl % 16;
      conv_tile_fp8(p.ec_w_down + eo, 1024, 1024, (u8*)WDN + (size_t)e * 1024 * 1408, 1408, kt_ * 64, nt_ * 64, 128.0f, 0, smem); }
  }
}

DI void phase_prologue(const Params& p, char* smem) {
  const int npairs = (960 + 256 + 768 + 256) / 2;
  for (int pr = BIDX(); pr < npairs; pr += GDIM()) {
    const int item = 2 * pr + (TIDX() >> 8);
    if (item < 960) conv_matrix_items(p.even_w_in, 1024, 3600, 3840, (u16*)(p.ws + OFF_WIN), 0, item, smem);
    else if (item < 1216) conv_matrix_items(p.even_w_out, 1024, 1024, 1024, (u16*)(p.ws + OFF_WOE), 0, item - 960, smem);
    else if (item < 1984) conv_matrix_items(p.da_w_in, 1024, 3072, 3072, (u16*)(p.ws + OFF_WQKV), 0, item - 1216, smem);
    else conv_matrix_items(p.da_w_out, 1024, 1024, 1024, (u16*)(p.ws + OFF_WOO), 0, item - 1984, smem);
  }
  for (int item = BIDX(); item < 3 * 5632 / 2; item += GDIM()) conv_moe_layer(p, 0, item, smem);
  float2* rope = (float2*)(p.ws + OFF_ROPE);
  for (int i = BIDX() * NTHR + TIDX(); i < 2048 * 32; i += GDIM() * NTHR) {
    const int pos = i >> 5, d = i & 31;
    const float inv = powf(10000.0f, -(float)(2 * d) / 64.0f);
    const float ang = (float)pos * inv;
    const double a = (double)ang;
    const double kk = rint(a * 0.15915494309189535);
    const float r = (float)(a - kk * 6.283185307179586);
    rope[i] = make_float2(__cosf(r), __sinf(r));
  }
}

DI void phase_conv0(const Params& p, const GroupCtx& G, char* smem) {
  u16* XB = (u16*)(p.ws + OFF_R2);
  const size_t n8 = (size_t)G.T * 128;
  for (size_t i = (size_t)BIDX() * NTHR + TIDX(); i < n8; i += (size_t)GDIM() * NTHR) {
    const float4 a = *(const float4*)(G.xin + i * 8), b = *(const float4*)(G.xin + i * 8 + 4);
    u32x4 o; o[0] = pk(a.x, a.y); o[1] = pk(a.z, a.w); o[2] = pk(b.x, b.y); o[3] = pk(b.z, b.w);
    *(u32x4*)(XB + i * 8) = o;
  }
}

DI void phase_gemm_in0(const Params& p, const GroupCtx& G, char* smem) {
  const u16* XB = (const u16*)(p.ws + OFF_R2);
  const u16* W = (const u16*)(p.ws + OFF_WIN);
  u16* PROJ = (u16*)(p.ws + OFF_R1);
  float* GATES = (float*)(p.ws + OFF_GATES);
  const int lane = TIDX() & 63, wid = TIDX() >> 6, wr = wid >> 2, wc = wid & 3, fr = lane & 15, fq = lane >> 4;
  const int nitems = (G.T >> 8) * 15;
  for (int item = VBID(); item < nitems; item += GDIM()) {
    int mt, nt; tile_decode(item, 15, mt, nt);
    f32x4 acc[8][4];
    gemm_tile<false>(XB, 1024, nullptr, mt * 256, W, 1024, nt * 256, 1024, acc, smem);
#pragma unroll
    for (int m = 0; m < 8; ++m) {
      const size_t row = (size_t)mt * 256 + wr * 128 + m * 16 + fr;
#pragma unroll
      for (int n = 0; n < 4; ++n) {
        const int col = nt * 256 + wc * 64 + n * 16 + 4 * fq;
        if (col < 3584) {
          u32x2 o; o[0] = pk(acc[m][n][0], acc[m][n][1]); o[1] = pk(acc[m][n][2], acc[m][n][3]);
          *(u32x2*)(PROJ + row * 3584 + col) = o;
        } else if (col < 3600) {
          const int c = col - 3584;
          f32x4 o;
#pragma unroll
          for (int j = 0; j < 4; ++j) o[j] = acc[m][n][j] + p.ml_gate_bias[c + j];
          *(f32x4*)(GATES + row * 16 + c) = o;
        }
      }
    }
  }
}

DI void phase_gemm_in1(const Params& p, const GroupCtx& G, char* smem) {
  const u16* XB = G.xb1;
  const u16* W = (const u16*)(p.ws + OFF_WQKV);
  u16* QKV = (u16*)(p.ws + OFF_R1);
  const float* rope = (const float*)(p.ws + OFF_ROPE);
  const int lane = TIDX() & 63, wid = TIDX() >> 6, wr = wid >> 2, wc = wid & 3, fr = lane & 15, fq = lane >> 4;
  const int nitems = (G.T >> 8) * 12;
  for (int item = VBID(); item < nitems; item += GDIM()) {
    int mt, nt; tile_decode(item, 12, mt, nt);
    f32x4 acc[8][4];
    gemm_tile<false>(XB, 1024, nullptr, mt * 256, W, 1024, nt * 256, 1024, acc, smem);
    const int cbase = nt * 256 + wc * 64;
    const int sec = cbase >> 10;
#pragma unroll
    for (int m = 0; m < 8; ++m) {
      const size_t row = (size_t)mt * 256 + wr * 128 + m * 16 + fr;
      if (sec < 2) {
        const int pos = (int)(row & 2047);
        const float sc = (sec == 0) ? 0.125f : 1.0f;
#pragma unroll
        for (int n = 0; n < 2; ++n) {
          const int d = n * 16 + 4 * fq;
          const float* rp = rope + ((size_t)pos * 32 + d) * 2;
          const f32x4 cs0 = *(const f32x4*)rp, cs1 = *(const f32x4*)(rp + 4);
          const float c[4] = {cs0[0], cs0[2], cs1[0], cs1[2]};
          const float s[4] = {cs0[1], cs0[3], cs1[1], cs1[3]};
          f32x4 o1, o2;
#pragma unroll
          for (int j = 0; j < 4; ++j) {
            const float x1 = acc[m][n][j], x2 = acc[m][n + 2][j];
            o1[j] = (x1 * c[j] - x2 * s[j]) * sc;
            o2[j] = (x1 * s[j] + x2 * c[j]) * sc;
          }
          acc[m][n] = o1; acc[m][n + 2] = o2;
        }
      }
#pragma unroll
      for (int n = 0; n < 4; ++n) {
        const int col = cbase + n * 16 + 4 * fq;
        u32x2 o; o[0] = pk(acc[m][n][0], acc[m][n][1]); o[1] = pk(acc[m][n][2], acc[m][n][3]);
        *(u32x2*)(QKV + row * 3072 + col) = o;
      }
    }
  }
}

DI void phase_gemm_out(const Params& p, const GroupCtx& G, int layer, char* smem) {
  const u16* Y = (const u16*)(p.ws + OFF_R3);
  const u16* W = (const u16*)(p.ws + (layer == 0 ? OFF_WOE : OFF_WOO));
  u16* MIX = (u16*)(p.ws + OFF_R1);
  const int lane = TIDX() & 63, wid = TIDX() >> 6, wr = wid >> 2, wc = wid & 3, fr = lane & 15, fq = lane >> 4;
  const int nitems = (G.T >> 8) * 4;
  for (int item = VBID(); item < nitems; item += GDIM()) {
    int mt, nt; tile_decode(item, 4, mt, nt);
    f32x4 acc[8][4];
    gemm_tile<false>(Y, 1024, nullptr, mt * 256, W, 1024, nt * 256, 1024, acc, smem);
#pragma unroll
    for (int m = 0; m < 8; ++m) {
      const size_t row = (size_t)mt * 256 + wr * 128 + m * 16 + fr;
#pragma unroll
      for (int n = 0; n < 4; ++n) {
        const int col = nt * 256 + wc * 64 + n * 16 + 4 * fq;
        u32x2 o; o[0] = pk(acc[m][n][0], acc[m][n][1]); o[1] = pk(acc[m][n][2], acc[m][n][3]);
        *(u32x2*)(MIX + row * 1024 + col) = o;
      }
    }
  }
}

DI void phase_gemm_gu(const Params& p, const GroupCtx& G, char* smem) {
  const u8* X1 = (const u8*)(p.ws + OFF_X1Q);
  const u8* WGU = (const u8*)(p.ws + OFF_WGU);
  const int* IDX = (const int*)(p.ws + OFF_IDX);
  u8* H = (u8*)(p.ws + OFF_R1);
  const int MT = G.cap >> 8;
  const int nitems = 16 * MT * 11;
  for (int item = VBID(); item < nitems; item += GDIM()) {
    const int e = item / (MT * 11); int mt, nt; tile_decode(item - e * (MT * 11), 11, mt, nt);
    f32x4 acc[8][4];
    gemm_tile_fp8<true>(X1, 1024, IDX + e * G.cap, mt * 256, WGU + (size_t)e * 2816 * 1024, 1024, nt * 256, 1024, acc, smem);
    const int lane = TIDX() & 63, wid = TIDX() >> 6, wr = wid >> 2, wc = wid & 3, fr = lane & 15, fq = lane >> 4;
#pragma unroll
    for (int m = 0; m < 8; ++m) {
      const size_t row = (size_t)e * G.cap + mt * 256 + wr * 128 + m * 16 + fr;
#pragma unroll
      for (int n = 0; n < 2; ++n) {
        const int f = (nt * 4 + wc) * 32 + n * 16 + 4 * fq;
        float hv[4];
#pragma unroll
        for (int j = 0; j < 4; ++j) {
          const float g = acc[m][n][j] * (1.0f / 64.0f), u = acc[m][n + 2][j] * (1.0f / 64.0f);
          hv[j] = g / (1.0f + __expf(-g)) * u;
        }
        *(u32*)(H + row * 1408 + f) = pk4_fp8(hv[0], hv[1], hv[2], hv[3]);
      }
    }
  }
}

DI void phase_gemm_dn(const Params& p, const GroupCtx& G, u16* YE, char* smem) {
  const u8* H = (const u8*)(p.ws + OFF_R1);
  const u8* WDN = (const u8*)(p.ws + OFF_WDN);
  const float* GATE = (const float*)(p.ws + OFF_GATE);
  const int lane = TIDX() & 63, wid = TIDX() >> 6, wr = wid >> 2, wc = wid & 3, fr = lane & 15, fq = lane >> 4;
  const int MT = G.cap >> 8;
  const int nitems = 16 * MT * 4;
  for (int item = VBID(); item < nitems; item += GDIM()) {
    const int e = item / (MT * 4); int mt, nt; tile_decode(item - e * (MT * 4), 4, mt, nt);
    f32x4 acc[8][4];
    gemm_tile_fp8<false>(H + ((size_t)e * G.cap + mt * 256) * 1408, 1408, nullptr, 0, WDN + (size_t)e * 1024 * 1408, 1408, nt * 256, 1408, acc, smem);
#pragma unroll
    for (int m = 0; m < 8; ++m) {
      const size_t row = (size_t)e * G.cap + mt * 256 + wr * 128 + m * 16 + fr;
      const float gate = GATE[row] * (64.0f / 128.0f);
#pragma unroll
      for (int n = 0; n < 4; ++n) {
        const int col = nt * 256 + wc * 64 + n * 16 + 4 * fq;
        *(u32*)((u8*)YE + row * 1024 + col) = pk4_fp8(acc[m][n][0] * gate, acc[m][n][1] * gate, acc[m][n][2] * gate, acc[m][n][3] * gate);
      }
    }
  }
}

struct NaCtx { int r, h, rs; size_t tokbase; };
DI NaCtx na_decode(int item) {
  NaCtx c; c.r = item & 31; c.h = (item >> 5) & 7; c.tokbase = (size_t)(item >> 8) * 2048;
  c.rs = min(max(c.r - 4, 0), 24);
  return c;
}
DI void na_loadV(const u16* P, const NaCtx& c, int tid, u32x4 (&R)[16]) {
#pragma unroll
  for (int k = 0; k < 16; ++k) {
    const int i = tid + 256 * k;
    const int key = i >> 3, pc = i & 7;
    R[k] = *(const u32x4*)(P + (c.tokbase + c.rs * 64 + key) * 3584 + 1024 + c.h * 64 + pc * 8);
  }
}

DI void na_phase(const Params& p, int n_pairs, char* smem0) {
  const int tid = TIDX() & 255, lane = tid & 63, wid = tid >> 6, fr = lane & 15, fq = lane >> 4;
  const int sub = TIDX() >> 8;
  char* smem = smem0 + sub * 75776;
  u16* sV = (u16*)smem;
  float* sR = (float*)(smem + 512 * 72 * 2);
  const u16* P = (const u16*)(p.ws + OFF_R1);
  u16* YM = (u16*)(p.ws + OFF_R3);
  const int gd = GDIM();
  const int cb = wid;
  const int bs = (cb == 0) ? 0 : (cb == 1) ? 8 : (cb == 2) ? 24 : 32;
  const int qc = cb * 16 + fr;
  const int wc0 = min(max(qc - 8, 0), 48);
  const unsigned vbase = (unsigned)(size_t)sV;
  const int q4 = (lane & 15) >> 2, p4 = lane & 3;
  int pair = VBID();
  u32x4 R[16];
  if (pair < n_pairs) { const NaCtx c0 = na_decode(2 * pair + sub); na_loadV(P, c0, tid, R); }
  while (pair < n_pairs) {
    const NaCtx c = na_decode(2 * pair + sub);
    const int r = c.r, h = c.h, rs = c.rs;
    const size_t qtok = c.tokbase + r * 64 + qc;
    bf16x8 qf[2];
    qf[0] = ld8(P + qtok * 3584 + h * 64 + fq * 8);
    qf[1] = ld8(P + qtok * 3584 + h * 64 + 32 + fq * 8);
    bf16x8 kfa[8][2];
#pragma unroll
    for (int f = 0; f < 8; ++f) {
      const int w = f >> 1, c0 = bs + (f & 1) * 16;
      const u16* kp = P + (c.tokbase + (rs + w) * 64 + c0 + fr) * 3584 + 512 + h * 64 + fq * 8;
      kfa[f][0] = ld8(kp); kfa[f][1] = ld8(kp + 32);
    }
    __syncthreads();
#pragma unroll
    for (int k = 0; k < 16; ++k) {
      const int i = tid + 256 * k;
      *(u32x4*)(sV + (i >> 3) * 72 + (i & 7) * 8) = R[k];
    }
    for (int i = tid; i < 465; i += 256) sR[i] = p.na_rpb[h * 465 + i];
    __syncthreads();
    const int next = pair + gd;
    bf16x8 kfb[8][2];
#pragma unroll
    for (int f = 0; f < 8; ++f) {
      const int w = 4 + (f >> 1), c0 = bs + (f & 1) * 16;
      const u16* kp = P + (c.tokbase + (rs + w) * 64 + c0 + fr) * 3584 + 512 + h * 64 + fq * 8;
      kfb[f][0] = ld8(kp); kfb[f][1] = ld8(kp + 32);
    }
    f32x4 s[16];
#pragma unroll
    for (int f = 0; f < 8; ++f) {
      f32x4 a = {0.f, 0.f, 0.f, 0.f};
      a = MFMA(kfa[f][0], qf[0], a);
      a = MFMA(kfa[f][1], qf[1], a);
      s[f] = a;
    }
#pragma unroll
    for (int f = 0; f < 8; ++f) {
      f32x4 a = {0.f, 0.f, 0.f, 0.f};
      a = MFMA(kfb[f][0], qf[0], a);
      a = MFMA(kfb[f][1], qf[1], a);
      s[8 + f] = a;
    }
    __builtin_amdgcn_sched_barrier(0);
    if (next < n_pairs) { const NaCtx cn = na_decode(2 * next + sub); na_loadV(P, cn, tid, R); }
    float mx = -INFINITY;
#pragma unroll
    for (int f = 0; f < 16; ++f) {
      const int w = f >> 1;
      const int dr = rs + w - r + 7;
#pragma unroll
      for (int j = 0; j < 4; ++j) {
        const int kc = bs + (f & 1) * 16 + 4 * fq + j;
        const bool valid = (kc >= wc0) && (kc < wc0 + 16);
        const int dc = min(max(kc - qc + 15, 0), 30);
        const float v = valid ? (s[f][j] * 0.125f + sR[dr * 31 + dc]) : -INFINITY;
        s[f][j] = v;
        mx = fmaxf(mx, v);
      }
    }
    mx = fmaxf(mx, __shfl_xor(mx, 16));
    mx = fmaxf(mx, __shfl_xor(mx, 32));
    float l = 0.f;
#pragma unroll
    for (int f = 0; f < 16; ++f)
#pragma unroll
      for (int j = 0; j < 4; ++j) {
        const float pv = __expf(s[f][j] - mx);
        s[f][j] = pv;
        l += pv;
      }
    l += __shfl_xor(l, 16);
    l += __shfl_xor(l, 32);
    f32x4 o[4];
#pragma unroll
    for (int cc = 0; cc < 4; ++cc) o[cc] = f32x4{0.f, 0.f, 0.f, 0.f};
#pragma unroll
    for (int w = 0; w < 8; ++w) {
      const bf16x8 pb = pack8(s[2 * w], s[2 * w + 1]);
      const int key0 = w * 64 + bs + 4 * fq + q4;
      bf16x8 va[4];
      tr_read_4x2(vbase + (unsigned)((key0 * 72 + 4 * p4) * 2), va);
#pragma unroll
      for (int cc = 0; cc < 4; ++cc) o[cc] = MFMA(va[cc], pb, o[cc]);
    }
    const float inv = 1.0f / l;
#pragma unroll
    for (int cc = 0; cc < 4; ++cc) {
      u32x2 ov; ov[0] = pk(o[cc][0] * inv, o[cc][1] * inv); ov[1] = pk(o[cc][2] * inv, o[cc][3] * inv);
      *(u32x2*)(YM + qtok * 1024 + h * 64 + 16 * cc + 4 * fq) = ov;
    }
    pair = next;
  }
}

DI float logsigmoidf(float x) { return fminf(x, 0.f) - log1pf(__expf(-fabsf(x))); }

DI void ml_item(const Params& p, const GroupCtx& G, int item, char* smem) {
  const int tid = TIDX(), lane = tid & 63, wid = tid >> 6, fr = lane & 15, fq = lane >> 4;
  const int eh = item & 1, dir = (item >> 1) & 1, h = (item >> 2) & 3, b = item >> 4;
  u16* sK = (u16*)smem;
  u16* sV = sK + 128 * 136;
  u16* sC = sV + 128 * 72;
  float* s_a = (float*)(sC + 80 * 136);
  float* s_M = s_a + 128;
  float* s_wi = s_a + 256;
  float* s_ws = s_a + 384;
  float* s_en = s_a + 512;
  float* s_sc = s_a + 640;
  const u16* P = (const u16*)(p.ws + OFF_R1);
  const float* GT = (const float*)(p.ws + OFF_GATES);
  u16* HOUT = (u16*)(p.ws + OFF_R4) + (size_t)dir * G.T * 512;
  const size_t tokbase = (size_t)b * 2048;
  const float kscale = 0.08838834764831845f;
  const unsigned kbase = (unsigned)(size_t)sK, vbase = (unsigned)(size_t)sV;
  const int q4 = (lane & 15) >> 2, p4 = lane & 3;
  const bf16x8 ones = {16256, 16256, 16256, 16256, 16256, 16256, 16256, 16256};
  f32x4 Cacc[5];
#pragma unroll
  for (int n = 0; n < 5; ++n) Cacc[n] = f32x4{0.f, 0.f, 0.f, 0.f};
  float mcarry = 0.f;
  u32x4 RK[4], RV[2];
  float gn[4] = {0.f, 0.f, 0.f, 0.f};
#define CTOK(cb_, tau) ((cb_) + (size_t)(dir ? 127 - (tau) : (tau)))
  auto prefetch = [&](size_t cb_) {
#pragma unroll
    for (int k = 0; k < 4; ++k) { const int i = tid + NTHR * k; RK[k] = *(const u32x4*)(P + CTOK(cb_, i >> 4) * 3584 + 2048 + h * 128 + (i & 15) * 8); }
#pragma unroll
    for (int k = 0; k < 2; ++k) { const int i = tid + NTHR * k; RV[k] = *(const u32x4*)(P + CTOK(cb_, i >> 3) * 3584 + 2560 + h * 128 + eh * 64 + (i & 7) * 8); }
    if (wid == 0) {
      gn[0] = GT[CTOK(cb_, 2 * lane) * 16 + dir * 4 + h];     gn[1] = GT[CTOK(cb_, 2 * lane + 1) * 16 + dir * 4 + h];
      gn[2] = GT[CTOK(cb_, 2 * lane) * 16 + 8 + dir * 4 + h]; gn[3] = GT[CTOK(cb_, 2 * lane + 1) * 16 + 8 + dir * 4 + h];
    }
  };
  prefetch(tokbase + (size_t)(dir ? 15 : 0) * 128);
  for (int cc = 0; cc < 16; ++cc) {
    const int chunk = dir ? 15 - cc : cc;
    const size_t cbase = tokbase + (size_t)chunk * 128;
#define TOK(tau) (cbase + (size_t)(dir ? 127 - (tau) : (tau)))
    __syncthreads();
#pragma unroll
    for (int k = 0; k < 4; ++k) { const int i = tid + NTHR * k; *(u32x4*)(sK + (i >> 4) * 136 + (i & 15) * 8) = RK[k]; }
#pragma unroll
    for (int k = 0; k < 2; ++k) { const int i = tid + NTHR * k; *(u32x4*)(sV + (i >> 3) * 72 + (i & 7) * 8) = RV[k]; }
    bf16x8 qf[4];
    {
      const u16* qp = P + TOK(16 * wid + fr) * 3584 + 1536 + h * 128 + fq * 8;
#pragma unroll
      for (int ks = 0; ks < 4; ++ks) qf[ks] = ld8(qp + ks * 32);
    }
#pragma unroll
    for (int n = 0; n < 5; ++n) {
      u32x2 o; o[0] = pk(Cacc[n][0], Cacc[n][1]); o[1] = pk(Cacc[n][2], Cacc[n][3]);
      *(u32x2*)(sC + (16 * n + fr) * 136 + 16 * wid + 4 * fq) = o;
    }
    if (wid == 0) {
      const int t0 = 2 * lane, t1 = 2 * lane + 1;
      const float ig0 = gn[0], ig1 = gn[1];
      const float lf0 = logsigmoidf(gn[2]);
      const float lf1 = logsigmoidf(gn[3]);
      const float ps = lf0 + lf1;
      float sc = ps;
#pragma unroll
      for (int o = 1; o < 64; o <<= 1) { const float t = __shfl_up(sc, o); if (lane >= o) sc += t; }
      const float excl = sc - ps;
      const float b0 = excl + lf0, b1 = sc;
      const float a0 = ig0 - b0, a1 = ig1 - b1;
      float sm = fmaxf(a0, a1);
#pragma unroll
      for (int o = 1; o < 64; o <<= 1) { const float t = __shfl_up(sm, o); if (lane >= o) sm = fmaxf(sm, t); }
      float exm = __shfl_up(sm, 1);
      if (lane == 0) exm = -INFINITY;
      const float pm0 = fmaxf(exm, a0), pm1 = sm;
      const float M0 = fmaxf(mcarry, pm0), M1 = fmaxf(mcarry, pm1);
      const float blast = __shfl(sc, 63), M127 = __shfl(M1, 63);
      s_a[t0] = a0; s_a[t1] = a1;
      s_M[t0] = M0; s_M[t1] = M1;
      s_wi[t0] = __expf(mcarry - M0); s_wi[t1] = __expf(mcarry - M1);
      s_en[t0] = __expf(-(b0 + M0)); s_en[t1] = __expf(-(b1 + M1));
      s_ws[t0] = __expf(a0 - M127) * kscale; s_ws[t1] = __expf(a1 - M127) * kscale;
      if (lane == 0) { s_sc[0] = __expf(mcarry - M127); s_sc[1] = blast + M127; }
    }
    __syncthreads();
    const float decay = s_sc[0];
    mcarry = s_sc[1];
    if (cc + 1 < 16) prefetch(tokbase + (size_t)(dir ? 14 - cc : cc + 1) * 128);
    {
      const int tb = wid;
      const int tl = 16 * tb + fr;
      f32x4 acc[5];
      const f32x4 wi = *(const f32x4*)(s_wi + 16 * tb + 4 * fq);
#pragma unroll
      for (int n = 0; n < 5; ++n) {
        f32x4 a = {0.f, 0.f, 0.f, 0.f};
#pragma unroll
        for (int ks = 0; ks < 4; ++ks) a = MFMA(qf[ks], ld8(sC + (16 * n + fr) * 136 + 32 * ks + 8 * fq), a);
#pragma unroll
        for (int j = 0; j < 4; ++j) a[j] *= wi[j];
        acc[n] = a;
      }
      const float Mt = s_M[tl];
      const int npair = (tb >> 1) + 1;
#pragma unroll 1
      for (int i = 0; i < npair; ++i) {
        f32x4 sf[2];
#pragma unroll
        for (int u = 0; u < 2; ++u) {
          const int sb = 2 * i + u;
          f32x4 a = {0.f, 0.f, 0.f, 0.f};
          if (sb <= tb) {
#pragma unroll
            for (int ks = 0; ks < 4; ++ks) a = MFMA(ld8(sK + (16 * sb + fr) * 136 + 32 * ks + 8 * fq), qf[ks], a);
          }
          const f32x4 av = *(const f32x4*)(s_a + 16 * sb + 4 * fq);
#pragma unroll
          for (int j = 0; j < 4; ++j) {
            const int si = 16 * sb + 4 * fq + j;
            a[j] = (si <= tl) ? a[j] * kscale * __expf(av[j] - Mt) : 0.f;
          }
          sf[u] = a;
        }
        const bf16x8 pa = pack8(sf[0], sf[1]);
        const int row0 = 32 * i + 4 * fq + q4;
#pragma unroll
        for (int n = 0; n < 4; ++n) {
          const unsigned a0 = vbase + (unsigned)((row0 * 72 + 16 * n + 4 * p4) * 2);
          acc[n] = MFMA(pa, tr_read2(a0, a0 + 16 * 72 * 2), acc[n]);
        }
        acc[4] = MFMA(pa, ones, acc[4]);
      }
      const f32x4 en = *(const f32x4*)(s_en + 16 * tb + 4 * fq);
#pragma unroll
      for (int j = 0; j < 4; ++j) {
        const int t = 16 * tb + 4 * fq + j;
        const float inv = 1.0f / fmaxf(fabsf(acc[4][j]), en[j]);
        u16* hp = HOUT + TOK(t) * 512 + h * 128 + eh * 64 + fr;
#pragma unroll
        for (int n = 0; n < 4; ++n) hp[16 * n] = (u16)(pk(acc[n][j] * inv, 0.f) & 0xffffu);
      }
    }
    __syncthreads();
    for (int i = tid; i < 128 * 16; i += NTHR) {
      const int tau = i >> 4, pc = i & 15;
      const float w = s_ws[tau];
      u32x4 v = *(u32x4*)(sK + tau * 136 + pc * 8);
#pragma unroll
      for (int k = 0; k < 4; ++k) v[k] = pk(bflo(v[k]) * w, bfhi(v[k]) * w);
      *(u32x4*)(sK + tau * 136 + pc * 8) = v;
    }
    __syncthreads();
#pragma unroll
    for (int n = 0; n < 5; ++n)
#pragma unroll
      for (int j = 0; j < 4; ++j) Cacc[n][j] *= decay;
#pragma unroll
    for (int ks = 0; ks < 4; ++ks) {
      const int row0 = 32 * ks + 4 * fq + q4;
      const unsigned ak = kbase + (unsigned)((row0 * 136 + 16 * wid + 4 * p4) * 2);
      const bf16x8 ka = tr_read2(ak, ak + 16 * 136 * 2);
#pragma unroll
      for (int n = 0; n < 5; ++n) {
        bf16x8 bv = ones;
        if (n < 4) {
          const unsigned a0 = vbase + (unsigned)((row0 * 72 + 16 * n + 4 * p4) * 2);
          bv = tr_read2(a0, a0 + 16 * 72 * 2);
        }
        Cacc[n] = MFMA(ka, bv, Cacc[n]);
      }
    }
#undef TOK
  }
#undef CTOK
}

DI void phase_mix0(const Params& p, const GroupCtx& G, char* smem) {
  const int n_ml = G.NB * 16;
  for (int item = VBID(); item < n_ml; item += GDIM()) ml_item(p, G, item, smem);
  na_phase(p, G.NB * 128, smem);
}

DI void phase_comb0(const Params& p, const GroupCtx& G) {
  const int lane = TIDX() & 63, wid = TIDX() >> 6;
  const u16* HF = (const u16*)(p.ws + OFF_R4);
  const u16* HB = HF + (size_t)G.T * 512;
  const u16* P = (const u16*)(p.ws + OFF_R1);
  u16* YM = (u16*)(p.ws + OFF_R3);
  const int col = (lane >> 4) * 128 + (lane & 15) * 8;
  for (int t = BIDX() * NWAV + wid; t < G.T; t += GDIM() * NWAV) {
    const u32x4 a = *(const u32x4*)(HF + (size_t)t * 512 + col), b = *(const u32x4*)(HB + (size_t)t * 512 + col);
    float x[8];
#pragma unroll
    for (int k = 0; k < 4; ++k) { x[2 * k] = bflo(a[k]) + bflo(b[k]); x[2 * k + 1] = bfhi(a[k]) + bfhi(b[k]); }
    float s = 0.f;
#pragma unroll
    for (int k = 0; k < 8; ++k) s += x[k];
#pragma unroll
    for (int o = 8; o >= 1; o >>= 1) s += __shfl_xor(s, o);
    const float mean = s * (1.0f / 128.0f);
    float v = 0.f;
#pragma unroll
    for (int k = 0; k < 8; ++k) { const float d = x[k] - mean; v += d * d; }
#pragma unroll
    for (int o = 8; o >= 1; o >>= 1) v += __shfl_xor(v, o);
    const float rstd = rsqrtf(v * (1.0f / 128.0f) + LN_EPS_F);
    const u32x4 ob = *(const u32x4*)(P + (size_t)t * 3584 + 3072 + col);
    float y[8];
#pragma unroll
    for (int k = 0; k < 8; ++k) {
      const float o = (k & 1) ? bfhi(ob[k >> 1]) : bflo(ob[k >> 1]);
      const float sg = 1.0f / (1.0f + __expf(-o));
      y[k] = sg * (x[k] - mean) * rstd * p.ml_norm_g[col + k];
    }
    u32x4 ov; ov[0] = pk(y[0], y[1]); ov[1] = pk(y[2], y[3]); ov[2] = pk(y[4], y[5]); ov[3] = pk(y[6], y[7]);
    *(u32x4*)(YM + (size_t)t * 1024 + 512 + col) = ov;
  }
}

constexpr size_t OFF_LSE = OFF_R1 + 402653184;

DI u16* da_partial(const Params& p, const GroupCtx& G, int br) {
  return br == 0 ? (u16*)(p.ws + OFF_R4) : (br == 1 ? G.p1 : (u16*)(p.ws + OFF_R3));
}

struct DaCtx { int br, g, sh, n, i0, h; size_t tokbase; };
DI DaCtx da_decode(int item) {
  DaCtx c;
  const int sub = item % 48, bh = item / 48;
  c.h = bh & 15;
  c.tokbase = (size_t)(bh >> 4) * 2048;
  int blk;
  if (sub < 16) { c.br = 0; c.g = 0; blk = sub; }
  else if (sub < 32) { c.br = 1; c.g = (sub - 16) >> 2; blk = (sub - 16) & 3; }
  else { c.br = 2; c.g = sub - 32; blk = 0; }
  c.sh = 2 * c.br; c.n = 2048 >> c.sh; c.i0 = blk * 128;
  return c;
}
DI void da_load(const u16* P, const DaCtx& c, int tid, int lane, int wid, u32x4 (&R)[9], bf16x8 (&Q)[2]) {
#pragma unroll
  for (int k = 0; k < 9; ++k) {
    const int i = tid + NTHR * k;
    const int kl = min(i >> 4, 271), pc = i & 15;
    const int u = min(max(c.i0 - 64 + kl, 0), c.n - 1);
    R[k] = *(const u32x4*)(P + (c.tokbase + ((size_t)u << c.sh) + c.g) * 3072 + 1024 + c.h * 64 + (pc >> 3) * 1024 + (pc & 7) * 8);
  }
  const int uq = c.i0 + 16 * wid + (lane & 15);
  const u16* qp = P + (c.tokbase + ((size_t)uq << c.sh) + c.g) * 3072 + c.h * 64 + (lane >> 4) * 8;
  Q[0] = ld8(qp); Q[1] = ld8(qp + 32);
}
DI void da_store(char* smem, int tid, const u32x4 (&R)[9]) {
  u16* sK = (u16*)smem;
  u16* sV = sK + 272 * 72;
#pragma unroll
  for (int k = 0; k < 9; ++k) {
    const int i = tid + NTHR * k;
    if (i < 272 * 16) {
      const int kl = i >> 4, pc = i & 15;
      *(u32x4*)((pc >> 3 ? sV : sK) + kl * 72 + (pc & 7) * 8) = R[k];
    }
  }
}
DI void da_compute(const Params& p, const GroupCtx& G, const DaCtx& c, const bf16x8 (&qf)[2], char* smem) {
  const int tid = TIDX(), lane = tid & 63, wid = tid >> 6, fr = lane & 15, fq = lane >> 4;
  const int br = c.br, g = c.g, sh = c.sh, n = c.n, i0 = c.i0, h = c.h;
  u16* sK = (u16*)smem;
  u16* sV = sK + 272 * 72;
  u16* PO = da_partial(p, G, br);
  float* LSE = (float*)(p.ws + OFF_LSE) + (size_t)br * G.T * 16;
  const int uq = i0 + 16 * wid + fr;
  const size_t qtok = c.tokbase + ((size_t)uq << sh) + g;
  f32x4 s[10];
  float mx = -INFINITY;
  const bool edge = (i0 - 64 + 16 * wid < 0) || (i0 - 64 + 16 * wid + 144 > n);
#pragma unroll
  for (int f = 0; f < 9; ++f) {
    const u16* kp = sK + (16 * wid + 16 * f + fr) * 72 + fq * 8;
    f32x4 a = {0.f, 0.f, 0.f, 0.f};
    a = MFMA(ld8(kp), qf[0], a);
    a = MFMA(ld8(kp + 32), qf[1], a);
    if (f == 0 || f == 8) {
#pragma unroll
      for (int j = 0; j < 4; ++j) {
        const int d = 16 * f - 64 + 4 * fq + j - fr;
        const bool valid = (f == 0) ? (d >= -64) : (d <= 64);
        a[j] = valid ? a[j] : -INFINITY;
      }
    }
    if (edge) {
#pragma unroll
      for (int j = 0; j < 4; ++j) {
        const int u = i0 - 64 + 16 * wid + 16 * f + 4 * fq + j;
        a[j] = ((u >= 0) && (u < n)) ? a[j] : -INFINITY;
      }
    }
#pragma unroll
    for (int j = 0; j < 4; ++j) mx = fmaxf(mx, a[j]);
    s[f] = a;
  }
  mx = fmaxf(mx, __shfl_xor(mx, 16));
  mx = fmaxf(mx, __shfl_xor(mx, 32));
  float l = 0.f;
#pragma unroll
  for (int f = 0; f < 9; ++f)
#pragma unroll
    for (int j = 0; j < 4; ++j) {
      const float pv = __expf(s[f][j] - mx);
      s[f][j] = pv;
      l += pv;
    }
  s[9] = f32x4{0.f, 0.f, 0.f, 0.f};
  l += __shfl_xor(l, 16);
  l += __shfl_xor(l, 32);
  f32x4 o[4];
#pragma unroll
  for (int cc = 0; cc < 4; ++cc) o[cc] = f32x4{0.f, 0.f, 0.f, 0.f};
  const unsigned vbase = (unsigned)(size_t)sV;
  const int q4 = (lane & 15) >> 2, p4 = lane & 3;
#pragma unroll
  for (int kk = 0; kk < 5; ++kk) {
    const bf16x8 pb = pack8(s[2 * kk], s[2 * kk + 1]);
    bf16x8 va[4];
    tr_read_4x2(vbase + (unsigned)((((16 * wid + 32 * kk + 4 * fq + q4) * 72) + 4 * p4) * 2), va);
#pragma unroll
    for (int cc = 0; cc < 4; ++cc) o[cc] = MFMA(va[cc], pb, o[cc]);
  }
  const float inv = 1.0f / l;
#pragma unroll
  for (int cc = 0; cc < 4; ++cc) {
    u32x2 ov; ov[0] = pk(o[cc][0] * inv, o[cc][1] * inv); ov[1] = pk(o[cc][2] * inv, o[cc][3] * inv);
    *(u32x2*)(PO + qtok * 1024 + h * 64 + 16 * cc + 4 * fq) = ov;
  }
  if (fq == 0) LSE[qtok * 16 + h] = mx + __logf(l);
}

DI void phase_mix1(const Params& p, const GroupCtx& G, char* smem) {
  const int tid = TIDX(), lane = tid & 63, wid = tid >> 6;
  const u16* P = (const u16*)(p.ws + OFF_R1);
  const int nitems = G.NB * 16 * 48;
  const int gd = GDIM();
  int item = VBID();
  u32x4 R[9];
  bf16x8 qn[2];
  DaCtx cn = da_decode(item < nitems ? item : 0);
  if (item < nitems) da_load(P, cn, tid, lane, wid, R, qn);
  while (item < nitems) {
    const DaCtx cc = cn;
    bf16x8 qc[2];
    qc[0] = qn[0]; qc[1] = qn[1];
    __syncthreads();
    da_store(smem, tid, R);
    __syncthreads();
    const int next = item + gd;
    if (next < nitems) { cn = da_decode(next); da_load(P, cn, tid, lane, wid, R, qn); }
    da_compute(p, G, cc, qc, smem);
    item = next;
  }
}

DI void phase_comb1(const Params& p, const GroupCtx& G) {
  const int lane = TIDX() & 63, wid = TIDX() >> 6;
  const u16* P0 = da_partial(p, G, 0);
  const u16* P1 = da_partial(p, G, 1);
  u16* P2 = da_partial(p, G, 2);
  const float* LSE = (const float*)(p.ws + OFF_LSE);
  const int hd = lane >> 2;
  for (int t = BIDX() * NWAV + wid; t < G.T; t += GDIM() * NWAV) {
    const float l0 = LSE[(size_t)t * 16 + hd], l1 = LSE[((size_t)G.T + t) * 16 + hd], l2 = LSE[((size_t)2 * G.T + t) * 16 + hd];
    const float mm = fmaxf(l0, fmaxf(l1, l2));
    const float e0 = __expf(l0 - mm), e1 = __expf(l1 - mm), e2 = __expf(l2 - mm);
    const float is = 1.0f / (e0 + e1 + e2);
    const float w0 = e0 * is, w1 = e1 * is, w2 = e2 * is;
#pragma unroll
    for (int hh = 0; hh < 2; ++hh) {
      const size_t off = (size_t)t * 1024 + lane * 16 + hh * 8;
      const u32x4 a = *(const u32x4*)(P0 + off), bb = *(const u32x4*)(P1 + off), c = *(const u32x4*)(P2 + off);
      u32x4 ov;
#pragma unroll
      for (int k = 0; k < 4; ++k)
        ov[k] = pk(w0 * bflo(a[k]) + w1 * bflo(bb[k]) + w2 * bflo(c[k]), w0 * bfhi(a[k]) + w1 * bfhi(bb[k]) + w2 * bfhi(c[k]));
      *(u32x4*)(P2 + off) = ov;
    }
  }
}

DI void phase_ln1(const Params& p, const GroupCtx& G, int layer, char* smem) {
  const int tid = TIDX(), lane = tid & 63, wid = tid >> 6;
  float* wT = (float*)smem;
  const float* wr = p.ec_router + (size_t)layer * 16384;
  __syncthreads();
  for (int i = tid; i < 16384; i += NTHR) wT[(i & 15) * 1024 + (i >> 4)] = wr[i];
  __syncthreads();
  const u16* MIX = (const u16*)(p.ws + OFF_R1);
  const u16* XB = G.xb1;
  u16* X1 = (u16*)(p.ws + OFF_R4);
  float* AFF = (float*)(p.ws + OFF_AFF);
  const float* gam = p.ln_mix_g + layer * 1024;
  const float* bet = p.ln_mix_b + layer * 1024;
  u32x4 nmx[2];
  f32x4 nxf[4];
  u32x4 nxb[2];
  auto ld_tok = [&](int t) {
#pragma unroll
    for (int hh = 0; hh < 2; ++hh) {
      const int c = hh * 512 + lane * 8;
      nmx[hh] = *(const u32x4*)(MIX + (size_t)t * 1024 + c);
      if (layer == 0) {
        nxf[2 * hh] = *(const f32x4*)(G.xin + (size_t)t * 1024 + c);
        nxf[2 * hh + 1] = *(const f32x4*)(G.xin + (size_t)t * 1024 + c + 4);
      } else {
        nxb[hh] = *(const u32x4*)(XB + (size_t)t * 1024 + c);
      }
    }
  };
  const int tstride = GDIM() * NWAV;
  int t = BIDX() * NWAV + wid;
  if (t < G.T) ld_tok(t);
  for (; t < G.T; t += tstride) {
    float v[16];
#pragma unroll
    for (int hh = 0; hh < 2; ++hh) {
      float xi[8];
      if (layer == 0) {
#pragma unroll
        for (int k = 0; k < 4; ++k) { xi[k] = nxf[2 * hh][k]; xi[4 + k] = nxf[2 * hh + 1][k]; }
      } else {
#pragma unroll
        for (int k = 0; k < 4; ++k) { xi[2 * k] = bflo(nxb[hh][k]); xi[2 * k + 1] = bfhi(nxb[hh][k]); }
      }
#pragma unroll
      for (int k = 0; k < 4; ++k) {
        v[hh * 8 + 2 * k] = DN_ALPHA_F * xi[2 * k] + bflo(nmx[hh][k]);
        v[hh * 8 + 2 * k + 1] = DN_ALPHA_F * xi[2 * k + 1] + bfhi(nmx[hh][k]);
      }
    }
    if (t + tstride < G.T) ld_tok(t + tstride);
    float s = 0.f;
#pragma unroll
    for (int k = 0; k < 16; ++k) s += v[k];
    const float mean = wave_sum(s) * (1.0f / 1024.0f);
    float q = 0.f;
#pragma unroll
    for (int k = 0; k < 16; ++k) { const float d = v[k] - mean; q += d * d; }
    const float rstd = rsqrtf(wave_sum(q) * (1.0f / 1024.0f) + LN_EPS_F);
#pragma unroll
    for (int hh = 0; hh < 2; ++hh) {
      const int c = hh * 512 + lane * 8;
      const float4 g0 = *(const float4*)(gam + c), g1 = *(const float4*)(gam + c + 4);
      const float4 b0 = *(const float4*)(bet + c), b1 = *(const float4*)(bet + c + 4);
      const float gg[8] = {g0.x, g0.y, g0.z, g0.w, g1.x, g1.y, g1.z, g1.w};
      const float bb[8] = {b0.x, b0.y, b0.z, b0.w, b1.x, b1.y, b1.z, b1.w};
#pragma unroll
      for (int k = 0; k < 8; ++k) v[hh * 8 + k] = (v[hh * 8 + k] - mean) * rstd * gg[k] + bb[k];
      u32x4 ov; ov[0] = pk(v[hh * 8 + 0], v[hh * 8 + 1]); ov[1] = pk(v[hh * 8 + 2], v[hh * 8 + 3]);
      ov[2] = pk(v[hh * 8 + 4], v[hh * 8 + 5]); ov[3] = pk(v[hh * 8 + 6], v[hh * 8 + 7]);
      *(u32x4*)(X1 + (size_t)t * 1024 + c) = ov;
      u32x2 oq; oq[0] = pk4_fp8(v[hh * 8 + 0], v[hh * 8 + 1], v[hh * 8 + 2], v[hh * 8 + 3]); oq[1] = pk4_fp8(v[hh * 8 + 4], v[hh * 8 + 5], v[hh * 8 + 6], v[hh * 8 + 7]);
      *(u32x2*)((u8*)(p.ws + OFF_X1Q) + (size_t)t * 1024 + c) = oq;
    }
    float d16[16];
#pragma unroll
    for (int e = 0; e < 16; ++e) {
      float d = 0.f;
#pragma unroll
      for (int hh = 0; hh < 2; ++hh) {
        const float* wp = wT + e * 1024 + hh * 512 + lane * 8;
        const f32x4 w0 = *(const f32x4*)wp, w1 = *(const f32x4*)(wp + 4);
#pragma unroll
        for (int k = 0; k < 4; ++k) { d += v[hh * 8 + k] * w0[k]; d += v[hh * 8 + 4 + k] * w1[k]; }
      }
      d16[e] = d;
      if ((e & 3) == 3) __builtin_amdgcn_sched_barrier(0);
    }
    float d8[8];
    {
      const bool hi = (lane & 8) != 0;
#pragma unroll
      for (int k = 0; k < 8; ++k) {
        const float keep = hi ? d16[8 + k] : d16[k];
        const float send = hi ? d16[k] : d16[8 + k];
        d8[k] = keep + __shfl_xor(send, 8);
      }
    }
    float d4[4];
    {
      const bool hi = (lane & 4) != 0;
#pragma unroll
      for (int k = 0; k < 4; ++k) {
        const float keep = hi ? d8[4 + k] : d8[k];
        const float send = hi ? d8[k] : d8[4 + k];
        d4[k] = keep + __shfl_xor(send, 4);
      }
    }
    float d2[2];
    {
      const bool hi = (lane & 2) != 0;
#pragma unroll
      for (int k = 0; k < 2; ++k) {
        const float keep = hi ? d4[2 + k] : d4[k];
        const float send = hi ? d4[k] : d4[2 + k];
        d2[k] = keep + __shfl_xor(send, 2);
      }
    }
    float mylogit;
    {
      const bool hi = (lane & 1) != 0;
      const float keep = hi ? d2[1] : d2[0];
      const float send = hi ? d2[0] : d2[1];
      mylogit = keep + __shfl_xor(send, 1);
    }
    mylogit += __shfl_xor(mylogit, 16);
    mylogit += __shfl_xor(mylogit, 32);
    float mx = mylogit;
#pragma unroll
    for (int o = 8; o >= 1; o >>= 1) mx = fmaxf(mx, __shfl_xor(mx, o));
    const float ex = __expf(mylogit - mx);
    float se = ex;
#pragma unroll
    for (int o = 8; o >= 1; o >>= 1) se += __shfl_xor(se, o);
    if (lane < 16) AFF[(size_t)lane * G.T + t] = ex / se;
  }
}

DI void phase_sel(const Params& p, const GroupCtx& G, char* smem) {
  if (BIDX() >= 16) return;
  const int tid = TIDX(), lane = tid & 63, wid = tid >> 6;
  const int e = BIDX(), T = G.T, cap = G.cap;
  const u32* a = (const u32*)(p.ws + OFF_AFF) + (size_t)e * T;
  int* IDX = (int*)(p.ws + OFF_IDX) + e * cap;
  float* GATE = (float*)(p.ws + OFF_GATE) + e * cap;
  int* SEL = (int*)(p.ws + OFF_SEL);
  int* red = (int*)smem;
  int* scn = red + 16;
  const int per = T >> 9;
  const int tbeg = tid * per;
  u32 v[128];
#pragma unroll
  for (int i = 0; i < 32; ++i) {
    u32x4 x = {0u, 0u, 0u, 0u};
    if (i * 4 < per) x = *(const u32x4*)(a + tbeg + i * 4);
    v[4 * i] = x[0]; v[4 * i + 1] = x[1]; v[4 * i + 2] = x[2]; v[4 * i + 3] = x[3];
  }
  __syncthreads();
  u32 lo = 0u, hi = 0x3F800001u;
  int it = 0;
  while (hi - lo > 1u) {
    const u32 mid = lo + ((hi - lo) >> 1);
    int c = 0;
#pragma unroll
    for (int i = 0; i < 128; ++i) c += (v[i] >= mid) ? 1 : 0;
#pragma unroll
    for (int o = 32; o >= 1; o >>= 1) c += __shfl_xor(c, o);
    const int par = it & 1;
    if (lane == 0) red[par * 8 + wid] = c;
    __syncthreads();
    int tot = 0;
#pragma unroll
    for (int w = 0; w < NWAV; ++w) tot += red[par * 8 + w];
    if (tot >= cap) lo = mid; else hi = mid;
    ++it;
  }
  const u32 thr = lo;
  int my_gt = 0, my_eq = 0;
#pragma unroll
  for (int i = 0; i < 128; ++i) { my_gt += (v[i] > thr) ? 1 : 0; my_eq += (v[i] == thr) ? 1 : 0; }
  int sg = my_gt, se = my_eq;
#pragma unroll
  for (int o = 1; o < 64; o <<= 1) {
    const int tg = __shfl_up(sg, o), te = __shfl_up(se, o);
    if (lane >= o) { sg += tg; se += te; }
  }
  __syncthreads();
  if (lane == 63) { scn[wid * 2] = sg; scn[wid * 2 + 1] = se; }
  __syncthreads();
  int base_gt = sg - my_gt, base_eq = se - my_eq, cnt_gt = 0;
#pragma unroll
  for (int w = 0; w < NWAV; ++w) {
    const int g_ = scn[w * 2], e_ = scn[w * 2 + 1];
    if (w < wid) { base_gt += g_; base_eq += e_; }
    cnt_gt += g_;
  }
  const int need = cap - cnt_gt;
#pragma unroll 1
  for (int i0 = 0; i0 < per; i0 += 16) {
    u32 w[16];
#pragma unroll
    for (int k = 0; k < 4; ++k) {
      const u32x4 x = *(const u32x4*)(a + tbeg + i0 + 4 * k);
      w[4 * k] = x[0]; w[4 * k + 1] = x[1]; w[4 * k + 2] = x[2]; w[4 * k + 3] = x[3];
    }
    int sl[16];
#pragma unroll
    for (int k = 0; k < 16; ++k) {
      const u32 u = w[k];
      int slot = -1;
      if (u > thr) slot = base_gt++;
      else if (u == thr) { const int r = base_eq++; if (r < need) slot = cnt_gt + r; }
      sl[k] = slot;
    }
#pragma unroll
    for (int k = 0; k < 16; ++k) {
      const int t = tbeg + i0 + k;
      if (sl[k] >= 0) { IDX[sl[k]] = t; GATE[sl[k]] = __uint_as_float(w[k]); }
      SEL[(size_t)t * 16 + e] = sl[k];
    }
  }
}

DI void phase_ln2(const Params& p, const GroupCtx& G, int layer, const u16* YE) {
  const int lane = TIDX() & 63, wid = TIDX() >> 6;
  const u16* X1 = (const u16*)(p.ws + OFF_R4);
  const int* SEL = (const int*)(p.ws + OFF_SEL);
  u16* XB = G.xb1;
  const float* gam = p.ln_ffn_g + layer * 1024;
  const float* bet = p.ln_ffn_b + layer * 1024;
  u32x4 nx1[2];
  int nsel = -1;
  auto ld_tok = [&](int t) {
    nx1[0] = *(const u32x4*)(X1 + (size_t)t * 1024 + lane * 8);
    nx1[1] = *(const u32x4*)(X1 + (size_t)t * 1024 + 512 + lane * 8);
    nsel = SEL[(size_t)t * 16 + (lane & 15)];
  };
  const int tstride = GDIM() * NWAV;
  int t = BIDX() * NWAV + wid;
  if (t < G.T) ld_tok(t);
  for (; t < G.T; t += tstride) {
    float v[16];
#pragma unroll
    for (int hh = 0; hh < 2; ++hh)
#pragma unroll
      for (int k = 0; k < 4; ++k) { v[hh * 8 + 2 * k] = DN_ALPHA_F * bflo(nx1[hh][k]); v[hh * 8 + 2 * k + 1] = DN_ALPHA_F * bfhi(nx1[hh][k]); }
    const int selv = nsel;
    if (t + tstride < G.T) ld_tok(t + tstride);
    unsigned msk = (unsigned)(__ballot(selv >= 0) & 0xffffull);
    while (msk) {
      int ee[4];
      u32x2 y[4][2];
#pragma unroll
      for (int k = 0; k < 4; ++k) {
        ee[k] = msk ? (__ffs(msk) - 1) : -1;
        if (msk) msk &= msk - 1;
      }
#pragma unroll
      for (int k = 0; k < 4; ++k) {
        if (ee[k] >= 0) {
          const int s = __shfl(selv, ee[k]);
          const u8* yp = (const u8*)YE + ((size_t)ee[k] * G.cap + s) * 1024;
          y[k][0] = *(const u32x2*)(yp + lane * 8);
          y[k][1] = *(const u32x2*)(yp + 512 + lane * 8);
        } else {
          y[k][0] = u32x2{0u, 0u}; y[k][1] = u32x2{0u, 0u};
        }
      }
#pragma unroll
      for (int k = 0; k < 4; ++k)
#pragma unroll
        for (int hh = 0; hh < 2; ++hh)
#pragma unroll
          for (int j = 0; j < 2; ++j) {
            const f32x2_t lo = __builtin_amdgcn_cvt_pk_f32_fp8((int)y[k][hh][j], false), hi = __builtin_amdgcn_cvt_pk_f32_fp8((int)y[k][hh][j], true);
            v[hh * 8 + 4 * j] += lo[0] * (1.0f / 64.0f); v[hh * 8 + 4 * j + 1] += lo[1] * (1.0f / 64.0f);
            v[hh * 8 + 4 * j + 2] += hi[0] * (1.0f / 64.0f); v[hh * 8 + 4 * j + 3] += hi[1] * (1.0f / 64.0f);
          }
    }
    float s = 0.f;
#pragma unroll
    for (int k = 0; k < 16; ++k) s += v[k];
    const float mean = wave_sum(s) * (1.0f / 1024.0f);
    float q = 0.f;
#pragma unroll
    for (int k = 0; k < 16; ++k) { const float d = v[k] - mean; q += d * d; }
    const float rstd = rsqrtf(wave_sum(q) * (1.0f / 1024.0f) + LN_EPS_F);
#pragma unroll
    for (int hh = 0; hh < 2; ++hh) {
      const int c = hh * 512 + lane * 8;
      const float4 g0 = *(const float4*)(gam + c), g1 = *(const float4*)(gam + c + 4);
      const float4 b0 = *(const float4*)(bet + c), b1 = *(const float4*)(bet + c + 4);
      const float gg[8] = {g0.x, g0.y, g0.z, g0.w, g1.x, g1.y, g1.z, g1.w};
      const float bb[8] = {b0.x, b0.y, b0.z, b0.w, b1.x, b1.y, b1.z, b1.w};
      float y[8];
#pragma unroll
      for (int k = 0; k < 8; ++k) y[k] = (v[hh * 8 + k] - mean) * rstd * gg[k] + bb[k];
      if (layer == 0) {
        u32x4 ov; ov[0] = pk(y[0], y[1]); ov[1] = pk(y[2], y[3]); ov[2] = pk(y[4], y[5]); ov[3] = pk(y[6], y[7]);
        *(u32x4*)(XB + (size_t)t * 1024 + c) = ov;
      } else {
        float* op = G.out + (size_t)t * 1024 + c;
        *(float4*)op = make_float4(y[0], y[1], y[2], y[3]);
        *(float4*)(op + 4) = make_float4(y[4], y[5], y[6], y[7]);
      }
    }
  }
}


#define XB_TMO      128
#define XB_XCNT(j)  (256  + 64 * (j))
#define XB_XSUB(j)  (1280 + 64 * (j))
#define XB_XGEN(j)  (2304 + 64 * (j))
#define XB_TOP      3328
#define XB_TOPGEN   3392
#define XCD_BAR_WORDS 3456
#define XB_SPIN_CAP (1u << 22)
DI unsigned xb_ld(unsigned* p)              { return __hip_atomic_load(p, __ATOMIC_RELAXED, __HIP_MEMORY_SCOPE_AGENT); }
DI unsigned xb_add(unsigned* p, unsigned v) { return __hip_atomic_fetch_add(p, v, __ATOMIC_RELAXED, __HIP_MEMORY_SCOPE_AGENT); }
DI unsigned xb_xcc_id() { return (unsigned)__builtin_amdgcn_s_getreg((3 << 11) | 20) & 0xFu; }
#define XB_SPIN(cond, bar) do { unsigned _sp = 0; while (cond) { __builtin_amdgcn_s_sleep(1); \
    if ((++_sp & 255u) == 0u) { if (xb_ld(&(bar)[XB_TMO])) break; if (_sp > XB_SPIN_CAP) { atomicAdd(&(bar)[XB_TMO], 1u); break; } } } } while (0)
struct XcdBarrier { unsigned* bar; unsigned x; volatile LAS unsigned* st; };
DI XcdBarrier xcd_barrier_post(unsigned* bar, volatile LAS unsigned* st) {
  XcdBarrier b; b.bar = bar; b.x = xb_xcc_id(); b.st = st;
  if (threadIdx.x == 0) (void)xb_add(&bar[XB_XCNT(b.x)], 1u);
  return b;
}
DI void xcd_barrier_complete(unsigned* bar, unsigned x, unsigned& nloc, unsigned& nx) {
  const unsigned G = gridDim.x * gridDim.y * gridDim.z;
  unsigned sum, cnt, mine, sp = 0u;
  for (;;) {
    sum = 0u; cnt = 0u; mine = 0u;
#pragma unroll
    for (unsigned j = 0; j < 16; ++j) { const unsigned c = xb_ld(&bar[XB_XCNT(j)]); sum += c; cnt += (c > 0u) ? 1u : 0u; mine = (j == x) ? c : mine; }
    if (sum == G) break;
    __builtin_amdgcn_s_sleep(1);
    if ((++sp & 255u) == 0u) { if (xb_ld(&bar[XB_TMO])) break; if (sp > XB_SPIN_CAP) { atomicAdd(&bar[XB_TMO], 1u); break; } }
  }
  nloc = mine > 0u ? mine : 1u; nx = cnt > 0u ? cnt : 1u;
}
DI void xcd_barrier(const XcdBarrier& b) {
  asm volatile("s_waitcnt vmcnt(0)" ::: "memory");
  __syncthreads();
  if (threadIdx.x == 0) {
    unsigned* bar = b.bar;
    __builtin_amdgcn_s_waitcnt(0);
    unsigned nloc = b.st[0], nx = b.st[1];
    if (nloc == 0u) { xcd_barrier_complete(bar, b.x, nloc, nx); b.st[0] = nloc; b.st[1] = nx; }
    const unsigned old = xb_add(&bar[XB_XSUB(b.x)], 1u);
    const unsigned gen = old / nloc;
    if (old + 1u == (gen + 1u) * nloc) {
      __builtin_amdgcn_fence(__ATOMIC_RELEASE, "agent");
      asm volatile("s_waitcnt vmcnt(0)" ::: "memory");
      const unsigned og = xb_add(&bar[XB_TOP], 1u);
      const unsigned tg = og / nx;
      if (og + 1u == (tg + 1u) * nx) xb_add(&bar[XB_TOPGEN], 1u);
      else XB_SPIN(xb_ld(&bar[XB_TOPGEN]) == tg, bar);
      __builtin_amdgcn_fence(__ATOMIC_ACQUIRE, "agent");
      xb_add(&bar[XB_XGEN(b.x)], 1u);
      asm volatile("s_waitcnt vmcnt(0)" ::: "memory");
    } else {
      XB_SPIN(xb_ld(&bar[XB_XGEN(b.x)]) == gen, bar);
      __builtin_amdgcn_fence(__ATOMIC_ACQUIRE, "agent");
      asm volatile("s_waitcnt vmcnt(0)" ::: "memory");
    }
  }
  __syncthreads();
}

DI void run_phase(const Params& p, int ph, char* smem) {
  if (ph == 0) { phase_prologue(p, smem); return; }
  int seg, s;
  if (ph <= 20) { seg = (ph - 1) / 10; s = (ph - 1) % 10; }
  else { seg = 2 + (ph - 21) / 9; s = 10 + (ph - 21) % 9; }
  const int g = seg & 1;
  GroupCtx G;
  float* out_p = p.out;
  float* out_s = p.out + (size_t)32768 * 1024;
  if (g == 0) { G.T = 32768; G.NB = 16; G.cap = 4096; G.xin = p.x_prompt; G.out = out_p; }
  else { G.T = 65536; G.NB = 32; G.cap = 8192; G.xin = p.x_sample; G.out = out_s; }
  G.xb1 = (g == 0) ? (u16*)out_p : (u16*)(p.ws + OFF_R2);
  G.p1 = (g == 0) ? ((u16*)out_p + (size_t)32768 * 1024) : (u16*)out_s;
  u16* YE0 = (u16*)out_s;
  u16* YE1 = (g == 0) ? (u16*)(p.ws + OFF_R3) : (u16*)(p.ws + OFF_R2);
  switch (s) {
    case 0: phase_conv0(p, G, smem); break;
    case 1: phase_gemm_in0(p, G, smem); break;
    case 2: phase_mix0(p, G, smem); break;
    case 3: phase_comb0(p, G); break;
    case 4: phase_gemm_out(p, G, 0, smem); break;
    case 5: phase_ln1(p, G, 0, smem); break;
    case 6: phase_sel(p, G, smem); break;
    case 7: phase_gemm_gu(p, G, smem); break;
    case 8: phase_gemm_dn(p, G, YE0, smem); break;
    case 9:
      phase_ln2(p, G, 0, YE0);
      if (g == 1) { for (int item = BIDX(); item < 3 * 5632 / 2; item += GDIM()) conv_moe_layer(p, 1, item, smem); }
      break;
    case 10: phase_gemm_in1(p, G, smem); break;
    case 11: phase_mix1(p, G, smem); break;
    case 12: phase_comb1(p, G); break;
    case 13: phase_gemm_out(p, G, 1, smem); break;
    case 14: phase_ln1(p, G, 1, smem); break;
    case 15: phase_sel(p, G, smem); break;
    case 16: phase_gemm_gu(p, G, smem); break;
    case 17: phase_gemm_dn(p, G, YE1, smem); break;
    case 18: phase_ln2(p, G, 1, YE1); break;
    default: break;
  }
}

#ifndef REPEAT_MASK
#define REPEAT_MASK 0
#endif
#ifndef DBG_STOP
#define DBG_STOP 0
#endif
#ifndef DBG_OFF
#define DBG_OFF OFF_R4
#endif
__global__ void __launch_bounds__(256, 2) dbg_dump(Params p) {
  const u16* src = (const u16*)(p.ws + DBG_OFF);
  const size_t n = (size_t)98304 * 1024, nsrc = (size_t)32768 * 1024;
  for (size_t i = (size_t)blockIdx.x * 256 + threadIdx.x; i < n; i += (size_t)gridDim.x * 256)
  {
    float v = (i < nsrc) ? __uint_as_float(((u32)src[i]) << 16) : 0.f;
    if (v != v) v = 1.0e6f; else if (fabsf(v) > 1.0e30f) v = 3.0e6f;
    p.out[i] = v;
  }
}
__global__ void __launch_bounds__(512) hybrid_mega(Params p, int ph_lo, int ph_hi) {
  extern __shared__ __attribute__((aligned(16))) char smem[];
  volatile LAS unsigned* xst = (volatile LAS unsigned*)((LAS char*)smem + (SMEM_BYTES - 16));
  if (threadIdx.x == 0) { xst[0] = 0u; xst[1] = 0u; }
  __syncthreads();
  const XcdBarrier xb = xcd_barrier_post((unsigned*)(p.ws + OFF_BAR), xst);
#pragma unroll 1
  for (int ph = ph_lo; ph < ph_hi; ++ph) {
    Params q = p;
#define LAUNDER(f) asm volatile("" : "+s"(q.f))
    LAUNDER(x_prompt); LAUNDER(x_sample); LAUNDER(even_w_in); LAUNDER(ml_gate_bias); LAUNDER(na_rpb); LAUNDER(ml_norm_g);
    LAUNDER(even_w_out); LAUNDER(da_w_in); LAUNDER(da_w_out); LAUNDER(ln_mix_g); LAUNDER(ln_mix_b); LAUNDER(ec_router);
    LAUNDER(ec_w_gate); LAUNDER(ec_w_up); LAUNDER(ec_w_down); LAUNDER(ln_ffn_g); LAUNDER(ln_ffn_b); LAUNDER(out); LAUNDER(ws);
#undef LAUNDER
    int reps = 1;
#if REPEAT_MASK
    if (ph > 0 && ((REPEAT_MASK >> (ph % 32)) & 1)) reps = 2;
#endif
#pragma unroll 1
    for (int rr = 0; rr < reps; ++rr) {
      if (rr) xcd_barrier(xb);
      run_phase(q, ph, smem);
    }
    if (ph + 1 < ph_hi) { if (ph == 0) cg::this_grid().sync(); else xcd_barrier(xb); }
  }
}

extern "C" void kernel_launch(void* const* d_in, const int* in_sizes, int n_in, void* d_out, int out_size,
                              void* d_ws, size_t ws_size, hipStream_t stream) {
  (void)in_sizes; (void)n_in; (void)out_size;
  Params p;
  memset(&p, 0, sizeof(p));
  p.x_prompt = (const float*)d_in[0];   p.x_sample = (const float*)d_in[1];
  p.even_w_in = (const float*)d_in[2];  p.ml_gate_bias = (const float*)d_in[3];
  p.na_rpb = (const float*)d_in[4];     p.ml_norm_g = (const float*)d_in[5];
  p.even_w_out = (const float*)d_in[6]; p.da_w_in = (const float*)d_in[7];
  p.da_w_out = (const float*)d_in[8];   p.ln_mix_g = (const float*)d_in[9];
  p.ln_mix_b = (const float*)d_in[10];  p.ec_router = (const float*)d_in[11];
  p.ec_w_gate = (const float*)d_in[12]; p.ec_w_up = (const float*)d_in[13];
  p.ec_w_down = (const float*)d_in[14]; p.ln_ffn_g = (const float*)d_in[15];
  p.ln_ffn_b = (const float*)d_in[16];
  p.out = (float*)d_out;
  p.ws = (char*)d_ws;
  if (ws_size < WS_NEEDED) { fprintf(stderr, "workspace too small: %zu < %zu\n", ws_size, (size_t)WS_NEEDED); return; }
  static int grid_blocks = 0;
  if (!grid_blocks) {
    int dev = 0, cus = 0, per_cu = 0;
    hipGetDevice(&dev);
    hipDeviceGetAttribute(&cus, hipDeviceAttributeMultiprocessorCount, dev);
    hipFuncSetAttribute((const void*)hybrid_mega, hipFuncAttributeMaxDynamicSharedMemorySize, SMEM_BYTES);
    hipOccupancyMaxActiveBlocksPerMultiprocessor(&per_cu, hybrid_mega, NTHR, SMEM_BYTES);
    if (per_cu < 1) per_cu = 1;
    if (per_cu > 1) per_cu = 1;
    grid_blocks = cus * per_cu;
  }
  hipMemsetAsync((char*)d_ws + OFF_BAR, 0, XCD_BAR_WORDS * 4, stream);
#if MULTI_LAUNCH
  for (int ph = 0; ph < (DBG_STOP ? DBG_STOP : NPHASES); ++ph) {
    hipLaunchKernelGGL(hybrid_mega, dim3(grid_blocks), dim3(NTHR), SMEM_BYTES, stream, p, ph, ph + 1);
  }
  if (DBG_STOP) hipLaunchKernelGGL(dbg_dump, dim3(grid_blocks), dim3(256), 0, stream, p);
#else
  int lo = 0, hi = NPHASES;
  void* args[] = {&p, &lo, &hi};
  hipError_t e = hipLaunchCooperativeKernel((void*)hybrid_mega, dim3(grid_blocks), dim3(NTHR), args, SMEM_BYTES, stream);
  if (e != hipSuccess) fprintf(stderr, "cooperative launch failed: %s (grid %d)\n", hipGetErrorString(e), grid_blocks);
#endif
}
```

```cpp
#include <hip/hip_runtime.h>
#include <hip/hip_cooperative_groups.h>
#include <cstdio>
#include <cstring>
namespace cg = cooperative_groups;

#ifndef MULTI_LAUNCH
#define MULTI_LAUNCH 0
#endif

typedef unsigned short u16;
typedef unsigned int u32;
using bf16x8 = __attribute__((ext_vector_type(8))) short;
using s16x4 = __attribute__((ext_vector_type(4))) short;
using f32x4 = __attribute__((ext_vector_type(4))) float;
using u32x4 = __attribute__((ext_vector_type(4))) unsigned;
using u32x2 = __attribute__((ext_vector_type(2))) unsigned;

#define DI __device__ __forceinline__
#define MFMA(a, b, c) __builtin_amdgcn_mfma_f32_16x16x32_bf16((a), (b), (c), 0, 0, 0)

constexpr int NPH_G = 19;
constexpr int NPHASES = 1 + 2 * 10 + 2 * 9;
constexpr int SMEM_BYTES = 155648;
constexpr int NTHR = 512;
constexpr int NWAV = 8;
#define LAS __attribute__((address_space(3)))
constexpr float DN_ALPHA_F = 1.41421356237309515f;
constexpr float LN_EPS_F = 1e-5f;

constexpr size_t OFF_WIN = 0;
constexpr size_t OFF_WOE = OFF_WIN + 7864320;
constexpr size_t OFF_WQKV = OFF_WOE + 2097152;
constexpr size_t OFF_WOO = OFF_WQKV + 6291456;
constexpr size_t OFF_ROPE = OFF_WOO + 2097152;
constexpr size_t OFF_WGU = OFF_ROPE + 524288;
constexpr size_t OFF_WDN = OFF_WGU + 92274688;
constexpr size_t OFF_AFF = OFF_WDN + 46137344;
constexpr size_t OFF_IDX = OFF_AFF + 4194304;
constexpr size_t OFF_GATE = OFF_IDX + 524288;
constexpr size_t OFF_SEL = OFF_GATE + 524288;
constexpr size_t OFF_GATES = OFF_SEL + 4194304;
constexpr size_t OFF_R1 = OFF_GATES + 4194304;
constexpr size_t OFF_X1Q = OFF_R1 + 201326592;
constexpr size_t OFF_R2 = OFF_R1 + 469762048;
constexpr size_t OFF_R3 = OFF_R2 + 134217728;
constexpr size_t OFF_R4 = OFF_R3 + 134217728;
constexpr size_t OFF_BAR = OFF_R4 + 134217728;
constexpr size_t WS_NEEDED = OFF_BAR + 16384;

struct Params {
  const float *x_prompt, *x_sample, *even_w_in, *ml_gate_bias, *na_rpb, *ml_norm_g, *even_w_out, *da_w_in, *da_w_out;
  const float *ln_mix_g, *ln_mix_b, *ec_router, *ec_w_gate, *ec_w_up, *ec_w_down, *ln_ffn_g, *ln_ffn_b;
  float* out;
  char* ws;
};

struct GroupCtx {
  int T, NB, cap;
  const float* xin;
  float* out;
  u16* xb1;
  u16* p1;
};

DI int TIDX() { int t = threadIdx.x; asm volatile("" : "+v"(t)); return t; }
DI int BIDX() { int t = blockIdx.x; asm volatile("" : "+s"(t)); return t; }
DI int GDIM() { int t = gridDim.x; asm volatile("" : "+s"(t)); return t; }
typedef float f32x2_t __attribute__((ext_vector_type(2)));
typedef __bf16 bf16x2_t __attribute__((ext_vector_type(2)));
DI u32 pk(float lo, float hi) { f32x2_t v = {lo, hi}; bf16x2_t b = __builtin_convertvector(v, bf16x2_t); return __builtin_bit_cast(u32, b); }
DI float bflo(u32 w) { return __uint_as_float(w << 16); }
DI float bfhi(u32 w) { return __uint_as_float(w & 0xffff0000u); }
DI bf16x8 ld8(const u16* p) { return *reinterpret_cast<const bf16x8*>(p); }
DI bf16x8 tr_read2(unsigned a0, unsigned a1) {
  s16x4 x, y;
  asm volatile("ds_read_b64_tr_b16 %0, %2\n\tds_read_b64_tr_b16 %1, %3\n\ts_waitcnt lgkmcnt(0)"
               : "=&v"(x), "=&v"(y) : "v"(a0), "v"(a1) : "memory");
  return __builtin_shufflevector(x, y, 0, 1, 2, 3, 4, 5, 6, 7);
}
DI void tr_read_4x2(unsigned base, bf16x8 (&out)[4]) {
  s16x4 x0, y0, x1, y1, x2, y2, x3, y3;
  asm volatile("ds_read_b64_tr_b16 %0, %8\n\t"
               "ds_read_b64_tr_b16 %1, %8 offset:2304\n\t"
               "ds_read_b64_tr_b16 %2, %8 offset:32\n\t"
               "ds_read_b64_tr_b16 %3, %8 offset:2336\n\t"
               "ds_read_b64_tr_b16 %4, %8 offset:64\n\t"
               "ds_read_b64_tr_b16 %5, %8 offset:2368\n\t"
               "ds_read_b64_tr_b16 %6, %8 offset:96\n\t"
               "ds_read_b64_tr_b16 %7, %8 offset:2400\n\t"
               "s_waitcnt lgkmcnt(0)"
               : "=&v"(x0), "=&v"(y0), "=&v"(x1), "=&v"(y1), "=&v"(x2), "=&v"(y2), "=&v"(x3), "=&v"(y3)
               : "v"(base) : "memory");
  out[0] = __builtin_shufflevector(x0, y0, 0, 1, 2, 3, 4, 5, 6, 7);
  out[1] = __builtin_shufflevector(x1, y1, 0, 1, 2, 3, 4, 5, 6, 7);
  out[2] = __builtin_shufflevector(x2, y2, 0, 1, 2, 3, 4, 5, 6, 7);
  out[3] = __builtin_shufflevector(x3, y3, 0, 1, 2, 3, 4, 5, 6, 7);
}
DI bf16x8 pack8(f32x4 a, f32x4 b) {
  u32x4 r; r[0] = pk(a[0], a[1]); r[1] = pk(a[2], a[3]); r[2] = pk(b[0], b[1]); r[3] = pk(b[2], b[3]);
  return __builtin_bit_cast(bf16x8, r);
}
DI float wave_sum(float v) {
#pragma unroll
  for (int o = 32; o >= 1; o >>= 1) v += __shfl_xor(v, o);
  return v;
}

DI int VBID() { const int b = BIDX(), g = GDIM(); return (g & 7) ? b : (b & 7) * (g >> 3) + (b >> 3); }
DI void tile_decode(int item, int NT, int& mt, int& nt) { const int mg = item / (NT * 8), rem = item - mg * (NT * 8); nt = rem >> 3; mt = mg * 8 + (rem & 7); }

template <bool GATHER>
DI void gemm_tile(const u16* __restrict__ A, int lda, const int* __restrict__ ridx, int row0,
                  const u16* __restrict__ Bt, int ldb, int col0, int K, f32x4 (&acc)[8][4], char* smem) {
  const int tid = TIDX(), lane = tid & 63, wid = tid >> 6, wr = wid >> 2, wc = wid & 3, fr = lane & 15, fq = lane >> 4;
  const int r0 = tid >> 3, pc = tid & 7;
  const int c = pc ^ ((r0 >> 1) & 7);
  unsigned pa[4];
#pragma unroll
  for (int i = 0; i < 4; ++i) {
    const int r = r0 + 64 * i;
    if (GATHER) pa[i] = (unsigned)ridx[row0 + r] * (unsigned)lda + c * 8;
    else pa[i] = (unsigned)(row0 + r) * (unsigned)lda + c * 8;
  }
  const u16* pb0 = Bt + (size_t)(col0 + r0) * ldb + c * 8;
  const size_t sb64 = (size_t)64 * ldb;
#pragma unroll
  for (int m = 0; m < 8; ++m)
#pragma unroll
    for (int n = 0; n < 4; ++n) acc[m][n] = f32x4{0.f, 0.f, 0.f, 0.f};
  const int key = (fr >> 1) & 7;
  const int p0 = (fq ^ key) * 16, p1 = ((fq ^ key) ^ 4) * 16;
  const char* rA = smem + (wr * 128 + fr) * 128;
  const char* rB = smem + 65536 + (wc * 64 + fr) * 128;
  LAS char* lds = (LAS char*)smem;
  const int wofs = tid * 16;
  const int nk = K >> 6;
#define G_STAGE(buf_, kt_) { const int ko_ = (kt_) * 64; _Pragma("unroll") for (int i = 0; i < 4; ++i) { \
      __builtin_amdgcn_global_load_lds((const unsigned*)(A + (size_t)pa[i] + ko_), (LAS unsigned*)(lds + (buf_) * 32768 + wofs + i * 8192), 16, 0, 0); \
      __builtin_amdgcn_global_load_lds((const unsigned*)(pb0 + i * sb64 + ko_), (LAS unsigned*)(lds + 65536 + (buf_) * 32768 + wofs + i * 8192), 16, 0, 0); } }
  __syncthreads();
  G_STAGE(0, 0);
  asm volatile("s_waitcnt vmcnt(0)" ::: "memory");
  __syncthreads();
  for (int kt = 0; kt < nk; ++kt) {
    const int cur = kt & 1;
    if (kt + 1 < nk) G_STAGE(cur ^ 1, kt + 1);
    const char* cA = rA + cur * 32768;
    const char* cB = rB + cur * 32768;
#pragma unroll
    for (int ks = 0; ks < 2; ++ks) {
      const int po = ks ? p1 : p0;
      bf16x8 bf[4];
#pragma unroll
      for (int n = 0; n < 4; ++n) bf[n] = *(const bf16x8*)(cB + n * 2048 + po);
#pragma unroll
      for (int mh = 0; mh < 2; ++mh) {
        bf16x8 af[4];
#pragma unroll
        for (int m = 0; m < 4; ++m) af[m] = *(const bf16x8*)(cA + (mh * 4 + m) * 2048 + po);
#pragma unroll
        for (int m = 0; m < 4; ++m)
#pragma unroll
          for (int n = 0; n < 4; ++n) acc[mh * 4 + m][n] = MFMA(bf[n], af[m], acc[mh * 4 + m][n]);
      }
    }
    asm volatile("s_waitcnt vmcnt(0)" ::: "memory");
    __syncthreads();
  }
#undef G_STAGE
}

typedef unsigned char u8;
DI u32 pk4_fp8(float a, float b, float c, float d) {
  int w = __builtin_amdgcn_cvt_pk_fp8_f32(a, b, 0, false);
  w = __builtin_amdgcn_cvt_pk_fp8_f32(c, d, w, true);
  return (u32)w;
}
template <bool GATHER>
DI void gemm_tile_fp8(const u8* __restrict__ A, int lda, const int* __restrict__ ridx, int row0, const u8* __restrict__ Bt, int ldb, int col0, int K,
                      f32x4 (&acc)[8][4], char* smem) {
  const int tid = TIDX(), lane = tid & 63, wid = tid >> 6, wr = wid >> 2, wc = wid & 3, fr = lane & 15, fq = lane >> 4;
  const int r0 = tid >> 3, pc = tid & 7;
  const int c = pc ^ ((r0 >> 1) & 7);
  unsigned pa[4];
#pragma unroll
  for (int i = 0; i < 4; ++i) pa[i] = (GATHER ? (unsigned)ridx[row0 + r0 + 64 * i] : (unsigned)(row0 + r0 + 64 * i)) * (unsigned)lda + c * 16;
  const u8* pb0 = Bt + (size_t)(col0 + r0) * ldb + c * 16;
  const size_t sb64 = (size_t)64 * ldb;
#pragma unroll
  for (int m = 0; m < 8; ++m)
#pragma unroll
    for (int n = 0; n < 4; ++n) acc[m][n] = f32x4{0.f, 0.f, 0.f, 0.f};
  const int key = (fr >> 1) & 7;
  const char* rA = smem + (wr * 128 + fr) * 128;
  const char* rB = smem + 65536 + (wc * 64 + fr) * 128;
  LAS char* lds = (LAS char*)smem;
  const int wofs = tid * 16;
  const int nk = K >> 7;
#define G8_STAGE(buf_, kt_) { const int ko_ = (kt_) * 128; _Pragma("unroll") for (int i = 0; i < 4; ++i) { \
      __builtin_amdgcn_global_load_lds((const unsigned*)(A + (size_t)pa[i] + ko_), (LAS unsigned*)(lds + (buf_) * 32768 + wofs + i * 8192), 16, 0, 0); \
      __builtin_amdgcn_global_load_lds((const unsigned*)(pb0 + i * sb64 + ko_), (LAS unsigned*)(lds + 65536 + (buf_) * 32768 + wofs + i * 8192), 16, 0, 0); } }
  __syncthreads();
  G8_STAGE(0, 0);
  asm volatile("s_waitcnt vmcnt(0)" ::: "memory");
  __syncthreads();
  for (int kt = 0; kt < nk; ++kt) {
    const int cur = kt & 1;
    if (kt + 1 < nk) G8_STAGE(cur ^ 1, kt + 1);
    const char* cA = rA + cur * 32768;
    const char* cB = rB + cur * 32768;
    typedef long long2_t __attribute__((ext_vector_type(2)));
#pragma unroll
    for (int jp = 0; jp < 2; ++jp) {
      const int po = ((4 * jp + fq) ^ key) * 16;
      long2_t bf[4];
#pragma unroll
      for (int n = 0; n < 4; ++n) bf[n] = *(const long2_t*)(cB + n * 2048 + po);
#pragma unroll
      for (int mh = 0; mh < 2; ++mh) {
        long2_t af[4];
#pragma unroll
        for (int m = 0; m < 4; ++m) af[m] = *(const long2_t*)(cA + (mh * 4 + m) * 2048 + po);
#pragma unroll
        for (int m = 0; m < 4; ++m)
#pragma unroll
          for (int n = 0; n < 4; ++n) {
            acc[mh * 4 + m][n] = __builtin_amdgcn_mfma_f32_16x16x32_fp8_fp8(bf[n][0], af[m][0], acc[mh * 4 + m][n], 0, 0, 0);
            acc[mh * 4 + m][n] = __builtin_amdgcn_mfma_f32_16x16x32_fp8_fp8(bf[n][1], af[m][1], acc[mh * 4 + m][n], 0, 0, 0);
          }
      }
    }
    asm volatile("s_waitcnt vmcnt(0)" ::: "memory");
    __syncthreads();
  }
#undef G8_STAGE
}

DI void conv_tile_fp8(const float* __restrict__ src, int N, int ldsrc, u8* __restrict__ dst, int lddst,
                      int k0, int n0, float scale, int mode, char* smem) {
  const int tid = TIDX() & 255;
  float* t = (float*)smem + (TIDX() >> 8) * 4160;
  __syncthreads();
#pragma unroll
  for (int i = 0; i < 4; ++i) {
    const int k = (tid >> 4) + 16 * i, n = (tid & 15) * 4;
    float4 v = make_float4(0.f, 0.f, 0.f, 0.f);
    if (n0 + n < N) v = *(const float4*)(src + (size_t)(k0 + k) * ldsrc + n0 + n);
    float* d = t + k * 65 + n;
    d[0] = v.x * scale; d[1] = v.y * scale; d[2] = v.z * scale; d[3] = v.w * scale;
  }
  __syncthreads();
#pragma unroll
  for (int i = 0; i < 2; ++i) {
    const int pidx = tid + 256 * i, n = pidx >> 3, kc = (pidx & 7) * 8;
    u32x2 o;
    o[0] = pk4_fp8(t[(kc + 0) * 65 + n], t[(kc + 1) * 65 + n], t[(kc + 2) * 65 + n], t[(kc + 3) * 65 + n]);
    o[1] = pk4_fp8(t[(kc + 4) * 65 + n], t[(kc + 5) * 65 + n], t[(kc + 6) * 65 + n], t[(kc + 7) * 65 + n]);
    const int nn = n0 + n;
    const int row = (mode == 0) ? nn : ((nn >> 5) * 64 + (nn & 31) + (mode == 2 ? 32 : 0));
    *(u32x2*)(dst + (size_t)row * lddst + k0 + kc) = o;
  }
}

DI void conv_tile(const float* __restrict__ src, int N, int ldsrc, u16* __restrict__ dst, int lddst,
                  int k0, int n0, int mode, char* smem) {
  const int tid = TIDX() & 255;
  float* t = (float*)smem + (TIDX() >> 8) * 4160;
  __syncthreads();
#pragma unroll
  for (int i = 0; i < 4; ++i) {
    const int k = (tid >> 4) + 16 * i, n = (tid & 15) * 4;
    float4 v = make_float4(0.f, 0.f, 0.f, 0.f);
    if (n0 + n < N) v = *(const float4*)(src + (size_t)(k0 + k) * ldsrc + n0 + n);
    float* d = t + k * 65 + n;
    d[0] = v.x; d[1] = v.y; d[2] = v.z; d[3] = v.w;
  }
  __syncthreads();
#pragma unroll
  for (int i = 0; i < 2; ++i) {
    const int pidx = tid + 256 * i, n = pidx >> 3, kc = (pidx & 7) * 8;
    u32x4 o;
    o[0] = pk(t[(kc + 0) * 65 + n], t[(kc + 1) * 65 + n]);
    o[1] = pk(t[(kc + 2) * 65 + n], t[(kc + 3) * 65 + n]);
    o[2] = pk(t[(kc + 4) * 65 + n], t[(kc + 5) * 65 + n]);
    o[3] = pk(t[(kc + 6) * 65 + n], t[(kc + 7) * 65 + n]);
    const int nn = n0 + n;
    const int row = (mode == 0) ? nn : ((nn >> 5) * 64 + (nn & 31) + (mode == 2 ? 32 : 0));
    *(u32x4*)(dst + (size_t)row * lddst + k0 + kc) = o;
  }
}

DI void conv_matrix_items(const float* src, int K, int N, int Npad, u16* dst, int mode, int item, char* smem) {
  const int ntn = Npad >> 6;
  const int kt = item / ntn, nt = item % ntn;
  conv_tile(src, N, N, dst, K, kt * 64, nt * 64, mode, smem);
}

DI void conv_moe_layer(const Params& p, int layer, int item, char* smem) {
  item = 2 * item + (TIDX() >> 8);
  const int which = item / 5632, r = item % 5632;
  const int e = r / 352, tl = r % 352;
  u16* WGU = (u16*)(p.ws + OFF_WGU);
  u16* WDN = (u16*)(p.ws + OFF_WDN);
  const size_t eo = ((size_t)layer * 16 + e) * (size_t)(1024 * 1408);
  if (which == 0) {
    conv_tile_fp8(p.ec_w_gate + eo, 1408, 1408, (u8*)WGU + (size_t)e * 2816 * 1024, 1024, (tl / 22) * 64, (tl % 22) * 64, 64.0f, 1, smem);
  } else if (which == 1) {
    conv_tile_fp8(p.ec_w_up + eo, 1408, 1408, (u8*)WGU + (size_t)e * 2816 * 1024, 1024, (tl / 22) * 64, (tl % 22) * 64, 64.0f, 2, smem);
  } else {
    { const int kt_ = tl / 16, nt_ = tl % 16;
      conv_tile_fp8(p.ec_w_down + eo, 1024, 1024, (u8*)WDN + (size_t)e * 1024 * 1408, 1408, kt_ * 64, nt_ * 64, 128.0f, 0, smem); }
  }
}

DI void phase_prologue(const Params& p, char* smem) {
  const int npairs = (960 + 256 + 768 + 256) / 2;
  for (int pr = BIDX(); pr < npairs; pr += GDIM()) {
    const int item = 2 * pr + (TIDX() >> 8);
    if (item < 960) conv_matrix_items(p.even_w_in, 1024, 3600, 3840, (u16*)(p.ws + OFF_WIN), 0, item, smem);
    else if (item < 1216) conv_matrix_items(p.even_w_out, 1024, 1024, 1024, (u16*)(p.ws + OFF_WOE), 0, item - 960, smem);
    else if (item < 1984) conv_matrix_items(p.da_w_in, 1024, 3072, 3072, (u16*)(p.ws + OFF_WQKV), 0, item - 1216, smem);
    else conv_matrix_items(p.da_w_out, 1024, 1024, 1024, (u16*)(p.ws + OFF_WOO), 0, item - 1984, smem);
  }
  for (int item = BIDX(); item < 3 * 5632 / 2; item += GDIM()) conv_moe_layer(p, 0, item, smem);
  float2* rope = (float2*)(p.ws + OFF_ROPE);
  for (int i = BIDX() * NTHR + TIDX(); i < 2048 * 32; i += GDIM() * NTHR) {
    const int pos = i >> 5, d = i & 31;
    const float inv = powf(10000.0f, -(float)(2 * d) / 64.0f);
    const float ang = (float)pos * inv;
    const double a = (double)ang;
    const double kk = rint(a * 0.15915494309189535);
    const float r = (float)(a - kk * 6.283185307179586);
    rope[i] = make_float2(__cosf(r), __sinf(r));
  }
}

DI void phase_conv0(const Params& p, const GroupCtx& G, char* smem) {
  u16* XB = (u16*)(p.ws + OFF_R2);
  const size_t n8 = (size_t)G.T * 128;
  for (size_t i = (size_t)BIDX() * NTHR + TIDX(); i < n8; i += (size_t)GDIM() * NTHR) {
    const float4 a = *(const float4*)(G.xin + i * 8), b = *(const float4*)(G.xin + i * 8 + 4);
    u32x4 o; o[0] = pk(a.x, a.y); o[1] = pk(a.z, a.w); o[2] = pk(b.x, b.y); o[3] = pk(b.z, b.w);
    *(u32x4*)(XB + i * 8) = o;
  }
}

DI void phase_gemm_in0(const Params& p, const GroupCtx& G, char* smem) {
  const u16* XB = (const u16*)(p.ws + OFF_R2);
  const u16* W = (const u16*)(p.ws + OFF_WIN);
  u16* PROJ = (u16*)(p.ws + OFF_R1);
  float* GATES = (float*)(p.ws + OFF_GATES);
  const int lane = TIDX() & 63, wid = TIDX() >> 6, wr = wid >> 2, wc = wid & 3, fr = lane & 15, fq = lane >> 4;
  const int nitems = (G.T >> 8) * 15;
  for (int item = VBID(); item < nitems; item += GDIM()) {
    int mt, nt; tile_decode(item, 15, mt, nt);
    f32x4 acc[8][4];
    gemm_tile<false>(XB, 1024, nullptr, mt * 256, W, 1024, nt * 256, 1024, acc, smem);
#pragma unroll
    for (int m = 0; m < 8; ++m) {
      const size_t row = (size_t)mt * 256 + wr * 128 + m * 16 + fr;
#pragma unroll
      for (int n = 0; n < 4; ++n) {
        const int col = nt * 256 + wc * 64 + n * 16 + 4 * fq;
        if (col < 3584) {
          u32x2 o; o[0] = pk(acc[m][n][0], acc[m][n][1]); o[1] = pk(acc[m][n][2], acc[m][n][3]);
          *(u32x2*)(PROJ + row * 3584 + col) = o;
        } else if (col < 3600) {
          const int c = col - 3584;
          f32x4 o;
#pragma unroll
          for (int j = 0; j < 4; ++j) o[j] = acc[m][n][j] + p.ml_gate_bias[c + j];
          *(f32x4*)(GATES + row * 16 + c) = o;
        }
      }
    }
  }
}

DI void phase_gemm_in1(const Params& p, const GroupCtx& G, char* smem) {
  const u16* XB = G.xb1;
  const u16* W = (const u16*)(p.ws + OFF_WQKV);
  u16* QKV = (u16*)(p.ws + OFF_R1);
  const float* rope = (const float*)(p.ws + OFF_ROPE);
  const int lane = TIDX() & 63, wid = TIDX() >> 6, wr = wid >> 2, wc = wid & 3, fr = lane & 15, fq = lane >> 4;
  const int nitems = (G.T >> 8) * 12;
  for (int item = VBID(); item < nitems; item += GDIM()) {
    int mt, nt; tile_decode(item, 12, mt, nt);
    f32x4 acc[8][4];
    gemm_tile<false>(XB, 1024, nullptr, mt * 256, W, 1024, nt * 256, 1024, acc, smem);
    const int cbase = nt * 256 + wc * 64;
    const int sec = cbase >> 10;
#pragma unroll
    for (int m = 0; m < 8; ++m) {
      const size_t row = (size_t)mt * 256 + wr * 128 + m * 16 + fr;
      if (sec < 2) {
        const int pos = (int)(row & 2047);
        const float sc = (sec == 0) ? 0.125f : 1.0f;
#pragma unroll
        for (int n = 0; n < 2; ++n) {
          const int d = n * 16 + 4 * fq;
          const float* rp = rope + ((size_t)pos * 32 + d) * 2;
          const f32x4 cs0 = *(const f32x4*)rp, cs1 = *(const f32x4*)(rp + 4);
          const float c[4] = {cs0[0], cs0[2], cs1[0], cs1[2]};
          const float s[4] = {cs0[1], cs0[3], cs1[1], cs1[3]};
          f32x4 o1, o2;
#pragma unroll
          for (int j = 0; j < 4; ++j) {
            const float x1 = acc[m][n][j], x2 = acc[m][n + 2][j];
            o1[j] = (x1 * c[j] - x2 * s[j]) * sc;
            o2[j] = (x1 * s[j] + x2 * c[j]) * sc;
          }
          acc[m][n] = o1; acc[m][n + 2] = o2;
        }
      }
#pragma unroll
      for (int n = 0; n < 4; ++n) {
        const int col = cbase + n * 16 + 4 * fq;
        u32x2 o; o[0] = pk(acc[m][n][0], acc[m][n][1]); o[1] = pk(acc[m][n][2], acc[m][n][3]);
        *(u32x2*)(QKV + row * 3072 + col) = o;
      }
    }
  }
}

DI void phase_gemm_out(const Params& p, const GroupCtx& G, int layer, char* smem) {
  const u16* Y = (const u16*)(p.ws + OFF_R3);
  const u16* W = (const u16*)(p.ws + (layer == 0 ? OFF_WOE : OFF_WOO));
  u16* MIX = (u16*)(p.ws + OFF_R1);
  const int lane = TIDX() & 63, wid = TIDX() >> 6, wr = wid >> 2, wc = wid & 3, fr = lane & 15, fq = lane >> 4;
  const int nitems = (G.T >> 8) * 4;
  for (int item = VBID(); item < nitems; item += GDIM()) {
    int mt, nt; tile_decode(item, 4, mt, nt);
    f32x4 acc[8][4];
    gemm_tile<false>(Y, 1024, nullptr, mt * 256, W, 1024, nt * 256, 1024, acc, smem);
#pragma unroll
    for (int m = 0; m < 8; ++m) {
      const size_t row = (size_t)mt * 256 + wr * 128 + m * 16 + fr;
#pragma unroll
      for (int n = 0; n < 4; ++n) {
        const int col = nt * 256 + wc * 64 + n * 16 + 4 * fq;
        u32x2 o; o[0] = pk(acc[m][n][0], acc[m][n][1]); o[1] = pk(acc[m][n][2], acc[m][n][3]);
        *(u32x2*)(MIX + row * 1024 + col) = o;
      }
    }
  }
}

DI void phase_gemm_gu(const Params& p, const GroupCtx& G, char* smem) {
  const u8* X1 = (const u8*)(p.ws + OFF_X1Q);
  const u8* WGU = (const u8*)(p.ws + OFF_WGU);
  const int* IDX = (const int*)(p.ws + OFF_IDX);
  u8* H = (u8*)(p.ws + OFF_R1);
  const int MT = G.cap >> 8;
  const int nitems = 16 * MT * 11;
  for (int item = VBID(); item < nitems; item += GDIM()) {
    const int e = item / (MT * 11); int mt, nt; tile_decode(item - e * (MT * 11), 11, mt, nt);
    f32x4 acc[8][4];
    gemm_tile_fp8<true>(X1, 1024, IDX + e * G.cap, mt * 256, WGU + (size_t)e * 2816 * 1024, 1024, nt * 256, 1024, acc, smem);
    const int lane = TIDX() & 63, wid = TIDX() >> 6, wr = wid >> 2, wc = wid & 3, fr = lane & 15, fq = lane >> 4;
#pragma unroll
    for (int m = 0; m < 8; ++m) {
      const size_t row = (size_t)e * G.cap + mt * 256 + wr * 128 + m * 16 + fr;
#pragma unroll
      for (int n = 0; n < 2; ++n) {
        const int f = (nt * 4 + wc) * 32 + n * 16 + 4 * fq;
        float hv[4];
#pragma unroll
        for (int j = 0; j < 4; ++j) {
          const float g = acc[m][n][j] * (1.0f / 64.0f), u = acc[m][n + 2][j] * (1.0f / 64.0f);
          hv[j] = g / (1.0f + __expf(-g)) * u;
        }
        *(u32*)(H + row * 1408 + f) = pk4_fp8(hv[0], hv[1], hv[2], hv[3]);
      }
    }
  }
}

DI void phase_gemm_dn(const Params& p, const GroupCtx& G, u16* YE, char* smem) {
  const u8* H = (const u8*)(p.ws + OFF_R1);
  const u8* WDN = (const u8*)(p.ws + OFF_WDN);
  const float* GATE = (const float*)(p.ws + OFF_GATE);
  const int lane = TIDX() & 63, wid = TIDX() >> 6, wr = wid >> 2, wc = wid & 3, fr = lane & 15, fq = lane >> 4;
  const int MT = G.cap >> 8;
  const int nitems = 16 * MT * 4;
  for (int item = VBID(); item < nitems; item += GDIM()) {
    const int e = item / (MT * 4); int mt, nt; tile_decode(item - e * (MT * 4), 4, mt, nt);
    f32x4 acc[8][4];
    gemm_tile_fp8<false>(H + ((size_t)e * G.cap + mt * 256) * 1408, 1408, nullptr, 0, WDN + (size_t)e * 1024 * 1408, 1408, nt * 256, 1408, acc, smem);
#pragma unroll
    for (int m = 0; m < 8; ++m) {
      const size_t row = (size_t)e * G.cap + mt * 256 + wr * 128 + m * 16 + fr;
      const float gate = GATE[row] * (64.0f / 128.0f);
#pragma unroll
      for (int n = 0; n < 4; ++n) {
        const int col = nt * 256 + wc * 64 + n * 16 + 4 * fq;
        *(u32*)((u8*)YE + row * 1024 + col) = pk4_fp8(acc[m][n][0] * gate, acc[m][n][1] * gate, acc[m][n][2] * gate, acc[m][n][3] * gate);
      }
    }
  }
}

struct NaCtx { int r, h, rs; size_t tokbase; };
DI NaCtx na_decode(int item) {
  NaCtx c; c.r = item & 31; c.h = (item >> 5) & 7; c.tokbase = (size_t)(item >> 8) * 2048;
  c.rs = min(max(c.r - 4, 0), 24);
  return c;
}
DI void na_loadV(const u16* P, const NaCtx& c, int tid, u32x4 (&R)[16]) {
#pragma unroll
  for (int k = 0; k < 16; ++k) {
    const int i = tid + 256 * k;
    const int key = i >> 3, pc = i & 7;
    R[k] = *(const u32x4*)(P + (c.tokbase + c.rs * 64 + key) * 3584 + 1024 + c.h * 64 + pc * 8);
  }
}

DI void na_phase(const Params& p, int n_pairs, char* smem0) {
  const int tid = TIDX() & 255, lane = tid & 63, wid = tid >> 6, fr = lane & 15, fq = lane >> 4;
  const int sub = TIDX() >> 8;
  char* smem = smem0 + sub * 75776;
  u16* sV = (u16*)smem;
  float* sR = (float*)(smem + 512 * 72 * 2);
  const u16* P = (const u16*)(p.ws + OFF_R1);
  u16* YM = (u16*)(p.ws + OFF_R3);
  const int gd = GDIM();
  const int cb = wid;
  const int bs = (cb == 0) ? 0 : (cb == 1) ? 8 : (cb == 2) ? 24 : 32;
  const int qc = cb * 16 + fr;
  const int wc0 = min(max(qc - 8, 0), 48);
  const unsigned vbase = (unsigned)(size_t)sV;
  const int q4 = (lane & 15) >> 2, p4 = lane & 3;
  int pair = VBID();
  u32x4 R[16];
  if (pair < n_pairs) { const NaCtx c0 = na_decode(2 * pair + sub); na_loadV(P, c0, tid, R); }
  while (pair < n_pairs) {
    const NaCtx c = na_decode(2 * pair + sub);
    const int r = c.r, h = c.h, rs = c.rs;
    const size_t qtok = c.tokbase + r * 64 + qc;
    bf16x8 qf[2];
    qf[0] = ld8(P + qtok * 3584 + h * 64 + fq * 8);
    qf[1] = ld8(P + qtok * 3584 + h * 64 + 32 + fq * 8);
    bf16x8 kfa[8][2];
#pragma unroll
    for (int f = 0; f < 8; ++f) {
      const int w = f >> 1, c0 = bs + (f & 1) * 16;
      const u16* kp = P + (c.tokbase + (rs + w) * 64 + c0 + fr) * 3584 + 512 + h * 64 + fq * 8;
      kfa[f][0] = ld8(kp); kfa[f][1] = ld8(kp + 32);
    }
    __syncthreads();
#pragma unroll
    for (int k = 0; k < 16; ++k) {
      const int i = tid + 256 * k;
      *(u32x4*)(sV + (i >> 3) * 72 + (i & 7) * 8) = R[k];
    }
    for (int i = tid; i < 465; i += 256) sR[i] = p.na_rpb[h * 465 + i];
    __syncthreads();
    const int next = pair + gd;
    bf16x8 kfb[8][2];
#pragma unroll
    for (int f = 0; f < 8; ++f) {
      const int w = 4 + (f >> 1), c0 = bs + (f & 1) * 16;
      const u16* kp = P + (c.tokbase + (rs + w) * 64 + c0 + fr) * 3584 + 512 + h * 64 + fq * 8;
      kfb[f][0] = ld8(kp); kfb[f][1] = ld8(kp + 32);
    }
    f32x4 s[16];
#pragma unroll
    for (int f = 0; f < 8; ++f) {
      f32x4 a = {0.f, 0.f, 0.f, 0.f};
      a = MFMA(kfa[f][0], qf[0], a);
      a = MFMA(kfa[f][1], qf[1], a);
      s[f] = a;
    }
#pragma unroll
    for (int f = 0; f < 8; ++f) {
      f32x4 a = {0.f, 0.f, 0.f, 0.f};
      a = MFMA(kfb[f][0], qf[0], a);
      a = MFMA(kfb[f][1], qf[1], a);
      s[8 + f] = a;
    }
    __builtin_amdgcn_sched_barrier(0);
    if (next < n_pairs) { const NaCtx cn = na_decode(2 * next + sub); na_loadV(P, cn, tid, R); }
    float mx = -INFINITY;
#pragma unroll
    for (int f = 0; f < 16; ++f) {
      const int w = f >> 1;
      const int dr = rs + w - r + 7;
#pragma unroll
      for (int j = 0; j < 4; ++j) {
        const int kc = bs + (f & 1) * 16 + 4 * fq + j;
        const bool valid = (kc >= wc0) && (kc < wc0 + 16);
        const int dc = min(max(kc - qc + 15, 0), 30);
        const float v = valid ? (s[f][j] * 0.125f + sR[dr * 31 + dc]) : -INFINITY;
        s[f][j] = v;
        mx = fmaxf(mx, v);
      }
    }
    mx = fmaxf(mx, __shfl_xor(mx, 16));
    mx = fmaxf(mx, __shfl_xor(mx, 32));
    float l = 0.f;
#pragma unroll
    for (int f = 0; f < 16; ++f)
#pragma unroll
      for (int j = 0; j < 4; ++j) {
        const float pv = __expf(s[f][j] - mx);
        s[f][j] = pv;
        l += pv;
      }
    l += __shfl_xor(l, 16);
    l += __shfl_xor(l, 32);
    f32x4 o[4];
#pragma unroll
    for (int cc = 0; cc < 4; ++cc) o[cc] = f32x4{0.f, 0.f, 0.f, 0.f};
#pragma unroll
    for (int w = 0; w < 8; ++w) {
      const bf16x8 pb = pack8(s[2 * w], s[2 * w + 1]);
      const int key0 = w * 64 + bs + 4 * fq + q4;
      bf16x8 va[4];
      tr_read_4x2(vbase + (unsigned)((key0 * 72 + 4 * p4) * 2), va);
#pragma unroll
      for (int cc = 0; cc < 4; ++cc) o[cc] = MFMA(va[cc], pb, o[cc]);
    }
    const float inv = 1.0f / l;
#pragma unroll
    for (int cc = 0; cc < 4; ++cc) {
      u32x2 ov; ov[0] = pk(o[cc][0] * inv, o[cc][1] * inv); ov[1] = pk(o[cc][2] * inv, o[cc][3] * inv);
      *(u32x2*)(YM + qtok * 1024 + h * 64 + 16 * cc + 4 * fq) = ov;
    }
    pair = next;
  }
}

DI float logsigmoidf(float x) { return fminf(x, 0.f) - log1pf(__expf(-fabsf(x))); }

DI void ml_item(const Params& p, const GroupCtx& G, int item, char* smem) {
  const int tid = TIDX(), lane = tid & 63, wid = tid >> 6, fr = lane & 15, fq = lane >> 4;
  const int eh = item & 1, dir = (item >> 1) & 1, h = (item >> 2) & 3, b = item >> 4;
  u16* sK = (u16*)smem;
  u16* sV = sK + 128 * 136;
  u16* sC = sV + 128 * 72;
  float* s_a = (float*)(sC + 80 * 136);
  float* s_M = s_a + 128;
  float* s_wi = s_a + 256;
  float* s_ws = s_a + 384;
  float* s_en = s_a + 512;
  float* s_sc = s_a + 640;
  const u16* P = (const u16*)(p.ws + OFF_R1);
  const float* GT = (const float*)(p.ws + OFF_GATES);
  u16* HOUT = (u16*)(p.ws + OFF_R4) + (size_t)dir * G.T * 512;
  const size_t tokbase = (size_t)b * 2048;
  const float kscale = 0.08838834764831845f;
  const unsigned kbase = (unsigned)(size_t)sK, vbase = (unsigned)(size_t)sV;
  const int q4 = (lane & 15) >> 2, p4 = lane & 3;
  const bf16x8 ones = {16256, 16256, 16256, 16256, 16256, 16256, 16256, 16256};
  f32x4 Cacc[5];
#pragma unroll
  for (int n = 0; n < 5; ++n) Cacc[n] = f32x4{0.f, 0.f, 0.f, 0.f};
  float mcarry = 0.f;
  u32x4 RK[4], RV[2];
  float gn[4] = {0.f, 0.f, 0.f, 0.f};
#define CTOK(cb_, tau) ((cb_) + (size_t)(dir ? 127 - (tau) : (tau)))
  auto prefetch = [&](size_t cb_) {
#pragma unroll
    for (int k = 0; k < 4; ++k) { const int i = tid + NTHR * k; RK[k] = *(const u32x4*)(P + CTOK(cb_, i >> 4) * 3584 + 2048 + h * 128 + (i & 15) * 8); }
#pragma unroll
    for (int k = 0; k < 2; ++k) { const int i = tid + NTHR * k; RV[k] = *(const u32x4*)(P + CTOK(cb_, i >> 3) * 3584 + 2560 + h * 128 + eh * 64 + (i & 7) * 8); }
    if (wid == 0) {
      gn[0] = GT[CTOK(cb_, 2 * lane) * 16 + dir * 4 + h];     gn[1] = GT[CTOK(cb_, 2 * lane + 1) * 16 + dir * 4 + h];
      gn[2] = GT[CTOK(cb_, 2 * lane) * 16 + 8 + dir * 4 + h]; gn[3] = GT[CTOK(cb_, 2 * lane + 1) * 16 + 8 + dir * 4 + h];
    }
  };
  prefetch(tokbase + (size_t)(dir ? 15 : 0) * 128);
  for (int cc = 0; cc < 16; ++cc) {
    const int chunk = dir ? 15 - cc : cc;
    const size_t cbase = tokbase + (size_t)chunk * 128;
#define TOK(tau) (cbase + (size_t)(dir ? 127 - (tau) : (tau)))
    __syncthreads();
#pragma unroll
    for (int k = 0; k < 4; ++k) { const int i = tid + NTHR * k; *(u32x4*)(sK + (i >> 4) * 136 + (i & 15) * 8) = RK[k]; }
#pragma unroll
    for (int k = 0; k < 2; ++k) { const int i = tid + NTHR * k; *(u32x4*)(sV + (i >> 3) * 72 + (i & 7) * 8) = RV[k]; }
    bf16x8 qf[4];
    {
      const u16* qp = P + TOK(16 * wid + fr) * 3584 + 1536 + h * 128 + fq * 8;
#pragma unroll
      for (int ks = 0; ks < 4; ++ks) qf[ks] = ld8(qp + ks * 32);
    }
#pragma unroll
    for (int n = 0; n < 5; ++n) {
      u32x2 o; o[0] = pk(Cacc[n][0], Cacc[n][1]); o[1] = pk(Cacc[n][2], Cacc[n][3]);
      *(u32x2*)(sC + (16 * n + fr) * 136 + 16 * wid + 4 * fq) = o;
    }
    if (wid == 0) {
      const int t0 = 2 * lane, t1 = 2 * lane + 1;
      const float ig0 = gn[0], ig1 = gn[1];
      const float lf0 = logsigmoidf(gn[2]);
      const float lf1 = logsigmoidf(gn[3]);
      const float ps = lf0 + lf1;
      float sc = ps;
#pragma unroll
      for (int o = 1; o < 64; o <<= 1) { const float t = __shfl_up(sc, o); if (lane >= o) sc += t; }
      const float excl = sc - ps;
      const float b0 = excl + lf0, b1 = sc;
      const float a0 = ig0 - b0, a1 = ig1 - b1;
      float sm = fmaxf(a0, a1);
#pragma unroll
      for (int o = 1; o < 64; o <<= 1) { const float t = __shfl_up(sm, o); if (lane >= o) sm = fmaxf(sm, t); }
      float exm = __shfl_up(sm, 1);
      if (lane == 0) exm = -INFINITY;
      const float pm0 = fmaxf(exm, a0), pm1 = sm;
      const float M0 = fmaxf(mcarry, pm0), M1 = fmaxf(mcarry, pm1);
      const float blast = __shfl(sc, 63), M127 = __shfl(M1, 63);
      s_a[t0] = a0; s_a[t1] = a1;
      s_M[t0] = M0; s_M[t1] = M1;
      s_wi[t0] = __expf(mcarry - M0); s_wi[t1] = __expf(mcarry - M1);
      s_en[t0] = __expf(-(b0 + M0)); s_en[t1] = __expf(-(b1 + M1));
      s_ws[t0] = __expf(a0 - M127) * kscale; s_ws[t1] = __expf(a1 - M127) * kscale;
      if (lane == 0) { s_sc[0] = __expf(mcarry - M127); s_sc[1] = blast + M127; }
    }
    __syncthreads();
    const float decay = s_sc[0];
    mcarry = s_sc[1];
    if (cc + 1 < 16) prefetch(tokbase + (size_t)(dir ? 14 - cc : cc + 1) * 128);
    {
      const int tb = wid;
      const int tl = 16 * tb + fr;
      f32x4 acc[5];
      const f32x4 wi = *(const f32x4*)(s_wi + 16 * tb + 4 * fq);
#pragma unroll
      for (int n = 0; n < 5; ++n) {
        f32x4 a = {0.f, 0.f, 0.f, 0.f};
#pragma unroll
        for (int ks = 0; ks < 4; ++ks) a = MFMA(qf[ks], ld8(sC + (16 * n + fr) * 136 + 32 * ks + 8 * fq), a);
#pragma unroll
        for (int j = 0; j < 4; ++j) a[j] *= wi[j];
        acc[n] = a;
      }
      const float Mt = s_M[tl];
      const int npair = (tb >> 1) + 1;
#pragma unroll 1
      for (int i = 0; i < npair; ++i) {
        f32x4 sf[2];
#pragma unroll
        for (int u = 0; u < 2; ++u) {
          const int sb = 2 * i + u;
          f32x4 a = {0.f, 0.f, 0.f, 0.f};
          if (sb <= tb) {
#pragma unroll
            for (int ks = 0; ks < 4; ++ks) a = MFMA(ld8(sK + (16 * sb + fr) * 136 + 32 * ks + 8 * fq), qf[ks], a);
          }
          const f32x4 av = *(const f32x4*)(s_a + 16 * sb + 4 * fq);
#pragma unroll
          for (int j = 0; j < 4; ++j) {
            const int si = 16 * sb + 4 * fq + j;
            a[j] = (si <= tl) ? a[j] * kscale * __expf(av[j] - Mt) : 0.f;
          }
          sf[u] = a;
        }
        const bf16x8 pa = pack8(sf[0], sf[1]);
        const int row0 = 32 * i + 4 * fq + q4;
#pragma unroll
        for (int n = 0; n < 4; ++n) {
          const unsigned a0 = vbase + (unsigned)((row0 * 72 + 16 * n + 4 * p4) * 2);
          acc[n] = MFMA(pa, tr_read2(a0, a0 + 16 * 72 * 2), acc[n]);
        }
        acc[4] = MFMA(pa, ones, acc[4]);
      }
      const f32x4 en = *(const f32x4*)(s_en + 16 * tb + 4 * fq);
#pragma unroll
      for (int j = 0; j < 4; ++j) {
        const int t = 16 * tb + 4 * fq + j;
        const float inv = 1.0f / fmaxf(fabsf(acc[4][j]), en[j]);
        u16* hp = HOUT + TOK(t) * 512 + h * 128 + eh * 64 + fr;
#pragma unroll
        for (int n = 0; n < 4; ++n) hp[16 * n] = (u16)(pk(acc[n][j] * inv, 0.f) & 0xffffu);
      }
    }
    __syncthreads();
    for (int i = tid; i < 128 * 16; i += NTHR) {
      const int tau = i >> 4, pc = i & 15;
      const float w = s_ws[tau];
      u32x4 v = *(u32x4*)(sK + tau * 136 + pc * 8);
#pragma unroll
      for (int k = 0; k < 4; ++k) v[k] = pk(bflo(v[k]) * w, bfhi(v[k]) * w);
      *(u32x4*)(sK + tau * 136 + pc * 8) = v;
    }
    __syncthreads();
#pragma unroll
    for (int n = 0; n < 5; ++n)
#pragma unroll
      for (int j = 0; j < 4; ++j) Cacc[n][j] *= decay;
#pragma unroll
    for (int ks = 0; ks < 4; ++ks) {
      const int row0 = 32 * ks + 4 * fq + q4;
      const unsigned ak = kbase + (unsigned)((row0 * 136 + 16 * wid + 4 * p4) * 2);
      const bf16x8 ka = tr_read2(ak, ak + 16 * 136 * 2);
#pragma unroll
      for (int n = 0; n < 5; ++n) {
        bf16x8 bv = ones;
        if (n < 4) {
          const unsigned a0 = vbase + (unsigned)((row0 * 72 + 16 * n + 4 * p4) * 2);
          bv = tr_read2(a0, a0 + 16 * 72 * 2);
        }
        Cacc[n] = MFMA(ka, bv, Cacc[n]);
      }
    }
#undef TOK
  }
#undef CTOK
}

DI void phase_mix0(const Params& p, const GroupCtx& G, char* smem) {
  const int n_ml = G.NB * 16;
  for (int item = VBID(); item < n_ml; item += GDIM()) ml_item(p, G, item, smem);
  na_phase(p, G.NB * 128, smem);
}

DI void phase_comb0(const Params& p, const GroupCtx& G) {
  const int lane = TIDX() & 63, wid = TIDX() >> 6;
  const u16* HF = (const u16*)(p.ws + OFF_R4);
  const u16* HB = HF + (size_t)G.T * 512;
  const u16* P = (const u16*)(p.ws + OFF_R1);
  u16* YM = (u16*)(p.ws + OFF_R3);
  const int col = (lane >> 4) * 128 + (lane & 15) * 8;
  for (int t = BIDX() * NWAV + wid; t < G.T; t += GDIM() * NWAV) {
    const u32x4 a = *(const u32x4*)(HF + (size_t)t * 512 + col), b = *(const u32x4*)(HB + (size_t)t * 512 + col);
    float x[8];
#pragma unroll
    for (int k = 0; k < 4; ++k) { x[2 * k] = bflo(a[k]) + bflo(b[k]); x[2 * k + 1] = bfhi(a[k]) + bfhi(b[k]); }
    float s = 0.f;
#pragma unroll
    for (int k = 0; k < 8; ++k) s += x[k];
#pragma unroll
    for (int o = 8; o >= 1; o >>= 1) s += __shfl_xor(s, o);
    const float mean = s * (1.0f / 128.0f);
    float v = 0.f;
#pragma unroll
    for (int k = 0; k < 8; ++k) { const float d = x[k] - mean; v += d * d; }
#pragma unroll
    for (int o = 8; o >= 1; o >>= 1) v += __shfl_xor(v, o);
    const float rstd = rsqrtf(v * (1.0f / 128.0f) + LN_EPS_F);
    const u32x4 ob = *(const u32x4*)(P + (size_t)t * 3584 + 3072 + col);
    float y[8];
#pragma unroll
    for (int k = 0; k < 8; ++k) {
      const float o = (k & 1) ? bfhi(ob[k >> 1]) : bflo(ob[k >> 1]);
      const float sg = 1.0f / (1.0f + __expf(-o));
      y[k] = sg * (x[k] - mean) * rstd * p.ml_norm_g[col + k];
    }
    u32x4 ov; ov[0] = pk(y[0], y[1]); ov[1] = pk(y[2], y[3]); ov[2] = pk(y[4], y[5]); ov[3] = pk(y[6], y[7]);
    *(u32x4*)(YM + (size_t)t * 1024 + 512 + col) = ov;
  }
}

constexpr size_t OFF_LSE = OFF_R1 + 402653184;

DI u16* da_partial(const Params& p, const GroupCtx& G, int br) {
  return br == 0 ? (u16*)(p.ws + OFF_R4) : (br == 1 ? G.p1 : (u16*)(p.ws + OFF_R3));
}

struct DaCtx { int br, g, sh, n, i0, h; size_t tokbase; };
DI DaCtx da_decode(int item) {
  DaCtx c;
  const int sub = item % 48, bh = item / 48;
  c.h = bh & 15;
  c.tokbase = (size_t)(bh >> 4) * 2048;
  int blk;
  if (sub < 16) { c.br = 0; c.g = 0; blk = sub; }
  else if (sub < 32) { c.br = 1; c.g = (sub - 16) >> 2; blk = (sub - 16) & 3; }
  else { c.br = 2; c.g = sub - 32; blk = 0; }
  c.sh = 2 * c.br; c.n = 2048 >> c.sh; c.i0 = blk * 128;
  return c;
}
DI void da_load(const u16* P, const DaCtx& c, int tid, int lane, int wid, u32x4 (&R)[9], bf16x8 (&Q)[2]) {
#pragma unroll
  for (int k = 0; k < 9; ++k) {
    const int i = tid + NTHR * k;
    const int kl = min(i >> 4, 271), pc = i & 15;
    const int u = min(max(c.i0 - 64 + kl, 0), c.n - 1);
    R[k] = *(const u32x4*)(P + (c.tokbase + ((size_t)u << c.sh) + c.g) * 3072 + 1024 + c.h * 64 + (pc >> 3) * 1024 + (pc & 7) * 8);
  }
  const int uq = c.i0 + 16 * wid + (lane & 15);
  const u16* qp = P + (c.tokbase + ((size_t)uq << c.sh) + c.g) * 3072 + c.h * 64 + (lane >> 4) * 8;
  Q[0] = ld8(qp); Q[1] = ld8(qp + 32);
}
DI void da_store(char* smem, int tid, const u32x4 (&R)[9]) {
  u16* sK = (u16*)smem;
  u16* sV = sK + 272 * 72;
#pragma unroll
  for (int k = 0; k < 9; ++k) {
    const int i = tid + NTHR * k;
    if (i < 272 * 16) {
      const int kl = i >> 4, pc = i & 15;
      *(u32x4*)((pc >> 3 ? sV : sK) + kl * 72 + (pc & 7) * 8) = R[k];
    }
  }
}
DI void da_compute(const Params& p, const GroupCtx& G, const DaCtx& c, const bf16x8 (&qf)[2], char* smem) {
  const int tid = TIDX(), lane = tid & 63, wid = tid >> 6, fr = lane & 15, fq = lane >> 4;
  const int br = c.br, g = c.g, sh = c.sh, n = c.n, i0 = c.i0, h = c.h;
  u16* sK = (u16*)smem;
  u16* sV = sK + 272 * 72;
  u16* PO = da_partial(p, G, br);
  float* LSE = (float*)(p.ws + OFF_LSE) + (size_t)br * G.T * 16;
  const int uq = i0 + 16 * wid + fr;
  const size_t qtok = c.tokbase + ((size_t)uq << sh) + g;
  f32x4 s[10];
  float mx = -INFINITY;
  const bool edge = (i0 - 64 + 16 * wid < 0) || (i0 - 64 + 16 * wid + 144 > n);
#pragma unroll
  for (int f = 0; f < 9; ++f) {
    const u16* kp = sK + (16 * wid + 16 * f + fr) * 72 + fq * 8;
    f32x4 a = {0.f, 0.f, 0.f, 0.f};
    a = MFMA(ld8(kp), qf[0], a);
    a = MFMA(ld8(kp + 32), qf[1], a);
    if (f == 0 || f == 8) {
#pragma unroll
      for (int j = 0; j < 4; ++j) {
        const int d = 16 * f - 64 + 4 * fq + j - fr;
        const bool valid = (f == 0) ? (d >= -64) : (d <= 64);
        a[j] = valid ? a[j] : -INFINITY;
      }
    }
    if (edge) {
#pragma unroll
      for (int j = 0; j < 4; ++j) {
        const int u = i0 - 64 + 16 * wid + 16 * f + 4 * fq + j;
        a[j] = ((u >= 0) && (u < n)) ? a[j] : -INFINITY;
      }
    }
#pragma unroll
    for (int j = 0; j < 4; ++j) mx = fmaxf(mx, a[j]);
    s[f] = a;
  }
  mx = fmaxf(mx, __shfl_xor(mx, 16));
  mx = fmaxf(mx, __shfl_xor(mx, 32));
  float l = 0.f;
#pragma unroll
  for (int f = 0; f < 9; ++f)
#pragma unroll
    for (int j = 0; j < 4; ++j) {
      const float pv = __expf(s[f][j] - mx);
      s[f][j] = pv;
      l += pv;
    }
  s[9] = f32x4{0.f, 0.f, 0.f, 0.f};
  l += __shfl_xor(l, 16);
  l += __shfl_xor(l, 32);
  f32x4 o[4];
#pragma unroll
  for (int cc = 0; cc < 4; ++cc) o[cc] = f32x4{0.f, 0.f, 0.f, 0.f};
  const unsigned vbase = (unsigned)(size_t)sV;
  const int q4 = (lane & 15) >> 2, p4 = lane & 3;
#pragma unroll
  for (int kk = 0; kk < 5; ++kk) {
    const bf16x8 pb = pack8(s[2 * kk], s[2 * kk + 1]);
    bf16x8 va[4];
    tr_read_4x2(vbase + (unsigned)((((16 * wid + 32 * kk + 4 * fq + q4) * 72) + 4 * p4) * 2), va);
#pragma unroll
    for (int cc = 0; cc < 4; ++cc) o[cc] = MFMA(va[cc], pb, o[cc]);
  }
  const float inv = 1.0f / l;
#pragma unroll
  for (int cc = 0; cc < 4; ++cc) {
    u32x2 ov; ov[0] = pk(o[cc][0] * inv, o[cc][1] * inv); ov[1] = pk(o[cc][2] * inv, o[cc][3] * inv);
    *(u32x2*)(PO + qtok * 1024 + h * 64 + 16 * cc + 4 * fq) = ov;
  }
  if (fq == 0) LSE[qtok * 16 + h] = mx + __logf(l);
}

DI void phase_mix1(const Params& p, const GroupCtx& G, char* smem) {
  const int tid = TIDX(), lane = tid & 63, wid = tid >> 6;
  const u16* P = (const u16*)(p.ws + OFF_R1);
  const int nitems = G.NB * 16 * 48;
  const int gd = GDIM();
  int item = VBID();
  u32x4 R[9];
  bf16x8 qn[2];
  DaCtx cn = da_decode(item < nitems ? item : 0);
  if (item < nitems) da_load(P, cn, tid, lane, wid, R, qn);
  while (item < nitems) {
    const DaCtx cc = cn;
    bf16x8 qc[2];
    qc[0] = qn[0]; qc[1] = qn[1];
    __syncthreads();
    da_store(smem, tid, R);
    __syncthreads();
    const int next = item + gd;
    if (next < nitems) { cn = da_decode(next); da_load(P, cn, tid, lane, wid, R, qn); }
    da_compute(p, G, cc, qc, smem);
    item = next;
  }
}

DI void phase_comb1(const Params& p, const GroupCtx& G) {
  const int lane = TIDX() & 63, wid = TIDX() >> 6;
  const u16* P0 = da_partial(p, G, 0);
  const u16* P1 = da_partial(p, G, 1);
  u16* P2 = da_partial(p, G, 2);
  const float* LSE = (const float*)(p.ws + OFF_LSE);
  const int hd = lane >> 2;
  for (int t = BIDX() * NWAV + wid; t < G.T; t += GDIM() * NWAV) {
    const float l0 = LSE[(size_t)t * 16 + hd], l1 = LSE[((size_t)G.T + t) * 16 + hd], l2 = LSE[((size_t)2 * G.T + t) * 16 + hd];
    const float mm = fmaxf(l0, fmaxf(l1, l2));
    const float e0 = __expf(l0 - mm), e1 = __expf(l1 - mm), e2 = __expf(l2 - mm);
    const float is = 1.0f / (e0 + e1 + e2);
    const float w0 = e0 * is, w1 = e1 * is, w2 = e2 * is;
#pragma unroll
    for (int hh = 0; hh < 2; ++hh) {
      const size_t off = (size_t)t * 1024 + lane * 16 + hh * 8;
      const u32x4 a = *(const u32x4*)(P0 + off), bb = *(const u32x4*)(P1 + off), c = *(const u32x4*)(P2 + off);
      u32x4 ov;
#pragma unroll
      for (int k = 0; k < 4; ++k)
        ov[k] = pk(w0 * bflo(a[k]) + w1 * bflo(bb[k]) + w2 * bflo(c[k]), w0 * bfhi(a[k]) + w1 * bfhi(bb[k]) + w2 * bfhi(c[k]));
      *(u32x4*)(P2 + off) = ov;
    }
  }
}

DI void phase_ln1(const Params& p, const GroupCtx& G, int layer, char* smem) {
  const int tid = TIDX(), lane = tid & 63, wid = tid >> 6;
  float* wT = (float*)smem;
  const float* wr = p.ec_router + (size_t)layer * 16384;
  __syncthreads();
  for (int i = tid; i < 16384; i += NTHR) wT[(i & 15) * 1024 + (i >> 4)] = wr[i];
  __syncthreads();
  const u16* MIX = (const u16*)(p.ws + OFF_R1);
  const u16* XB = G.xb1;
  u16* X1 = (u16*)(p.ws + OFF_R4);
  float* AFF = (float*)(p.ws + OFF_AFF);
  const float* gam = p.ln_mix_g + layer * 1024;
  const float* bet = p.ln_mix_b + layer * 1024;
  u32x4 nmx[2];
  f32x4 nxf[4];
  u32x4 nxb[2];
  auto ld_tok = [&](int t) {
#pragma unroll
    for (int hh = 0; hh < 2; ++hh) {
      const int c = hh * 512 + lane * 8;
      nmx[hh] = *(const u32x4*)(MIX + (size_t)t * 1024 + c);
      if (layer == 0) {
        nxf[2 * hh] = *(const f32x4*)(G.xin + (size_t)t * 1024 + c);
        nxf[2 * hh + 1] = *(const f32x4*)(G.xin + (size_t)t * 1024 + c + 4);
      } else {
        nxb[hh] = *(const u32x4*)(XB + (size_t)t * 1024 + c);
      }
    }
  };
  const int tstride = GDIM() * NWAV;
  int t = BIDX() * NWAV + wid;
  if (t < G.T) ld_tok(t);
  for (; t < G.T; t += tstride) {
    float v[16];
#pragma unroll
    for (int hh = 0; hh < 2; ++hh) {
      float xi[8];
      if (layer == 0) {
#pragma unroll
        for (int k = 0; k < 4; ++k) { xi[k] = nxf[2 * hh][k]; xi[4 + k] = nxf[2 * hh + 1][k]; }
      } else {
#pragma unroll
        for (int k = 0; k < 4; ++k) { xi[2 * k] = bflo(nxb[hh][k]); xi[2 * k + 1] = bfhi(nxb[hh][k]); }
      }
#pragma unroll
      for (int k = 0; k < 4; ++k) {
        v[hh * 8 + 2 * k] = DN_ALPHA_F * xi[2 * k] + bflo(nmx[hh][k]);
        v[hh * 8 + 2 * k + 1] = DN_ALPHA_F * xi[2 * k + 1] + bfhi(nmx[hh][k]);
      }
    }
    if (t + tstride < G.T) ld_tok(t + tstride);
    float s = 0.f;
#pragma unroll
    for (int k = 0; k < 16; ++k) s += v[k];
    const float mean = wave_sum(s) * (1.0f / 1024.0f);
    float q = 0.f;
#pragma unroll
    for (int k = 0; k < 16; ++k) { const float d = v[k] - mean; q += d * d; }
    const float rstd = rsqrtf(wave_sum(q) * (1.0f / 1024.0f) + LN_EPS_F);
#pragma unroll
    for (int hh = 0; hh < 2; ++hh) {
      const int c = hh * 512 + lane * 8;
      const float4 g0 = *(const float4*)(gam + c), g1 = *(const float4*)(gam + c + 4);
      const float4 b0 = *(const float4*)(bet + c), b1 = *(const float4*)(bet + c + 4);
      const float gg[8] = {g0.x, g0.y, g0.z, g0.w, g1.x, g1.y, g1.z, g1.w};
      const float bb[8] = {b0.x, b0.y, b0.z, b0.w, b1.x, b1.y, b1.z, b1.w};
#pragma unroll
      for (int k = 0; k < 8; ++k) v[hh * 8 + k] = (v[hh * 8 + k] - mean) * rstd * gg[k] + bb[k];
      u32x4 ov; ov[0] = pk(v[hh * 8 + 0], v[hh * 8 + 1]); ov[1] = pk(v[hh * 8 + 2], v[hh * 8 + 3]);
      ov[2] = pk(v[hh * 8 + 4], v[hh * 8 + 5]); ov[3] = pk(v[hh * 8 + 6], v[hh * 8 + 7]);
      *(u32x4*)(X1 + (size_t)t * 1024 + c) = ov;
      u32x2 oq; oq[0] = pk4_fp8(v[hh * 8 + 0], v[hh * 8 + 1], v[hh * 8 + 2], v[hh * 8 + 3]); oq[1] = pk4_fp8(v[hh * 8 + 4], v[hh * 8 + 5], v[hh * 8 + 6], v[hh * 8 + 7]);
      *(u32x2*)((u8*)(p.ws + OFF_X1Q) + (size_t)t * 1024 + c) = oq;
    }
    float d16[16];
#pragma unroll
    for (int e = 0; e < 16; ++e) {
      float d = 0.f;
#pragma unroll
      for (int hh = 0; hh < 2; ++hh) {
        const float* wp = wT + e * 1024 + hh * 512 + lane * 8;
        const f32x4 w0 = *(const f32x4*)wp, w1 = *(const f32x4*)(wp + 4);
#pragma unroll
        for (int k = 0; k < 4; ++k) { d += v[hh * 8 + k] * w0[k]; d += v[hh * 8 + 4 + k] * w1[k]; }
      }
      d16[e] = d;
      if ((e & 3) == 3) __builtin_amdgcn_sched_barrier(0);
    }
    float d8[8];
    {
      const bool hi = (lane & 8) != 0;
#pragma unroll
      for (int k = 0; k < 8; ++k) {
        const float keep = hi ? d16[8 + k] : d16[k];
        const float send = hi ? d16[k] : d16[8 + k];
        d8[k] = keep + __shfl_xor(send, 8);
      }
    }
    float d4[4];
    {
      const bool hi = (lane & 4) != 0;
#pragma unroll
      for (int k = 0; k < 4; ++k) {
        const float keep = hi ? d8[4 + k] : d8[k];
        const float send = hi ? d8[k] : d8[4 + k];
        d4[k] = keep + __shfl_xor(send, 4);
      }
    }
    float d2[2];
    {
      const bool hi = (lane & 2) != 0;
#pragma unroll
      for (int k = 0; k < 2; ++k) {
        const float keep = hi ? d4[2 + k] : d4[k];
        const float send = hi ? d4[k] : d4[2 + k];
        d2[k] = keep + __shfl_xor(send, 2);
      }
    }
    float mylogit;
    {
      const bool hi = (lane & 1) != 0;
      const float keep = hi ? d2[1] : d2[0];
      const float send = hi ? d2[0] : d2[1];
      mylogit = keep + __shfl_xor(send, 1);
    }
    mylogit += __shfl_xor(mylogit, 16);
    mylogit += __shfl_xor(mylogit, 32);
    float mx = mylogit;
#pragma unroll
    for (int o = 8; o >= 1; o >>= 1) mx = fmaxf(mx, __shfl_xor(mx, o));
    const float ex = __expf(mylogit - mx);
    float se = ex;
#pragma unroll
    for (int o = 8; o >= 1; o >>= 1) se += __shfl_xor(se, o);
    if (lane < 16) AFF[(size_t)lane * G.T + t] = ex / se;
  }
}

DI void phase_sel(const Params& p, const GroupCtx& G, char* smem) {
  if (BIDX() >= 16) return;
  const int tid = TIDX(), lane = tid & 63, wid = tid >> 6;
  const int e = BIDX(), T = G.T, cap = G.cap;
  const u32* a = (const u32*)(p.ws + OFF_AFF) + (size_t)e * T;
  int* IDX = (int*)(p.ws + OFF_IDX) + e * cap;
  float* GATE = (float*)(p.ws + OFF_GATE) + e * cap;
  int* SEL = (int*)(p.ws + OFF_SEL);
  int* red = (int*)smem;
  int* scn = red + 16;
  const int per = T >> 9;
  const int tbeg = tid * per;
  u32 v[128];
#pragma unroll
  for (int i = 0; i < 32; ++i) {
    u32x4 x = {0u, 0u, 0u, 0u};
    if (i * 4 < per) x = *(const u32x4*)(a + tbeg + i * 4);
    v[4 * i] = x[0]; v[4 * i + 1] = x[1]; v[4 * i + 2] = x[2]; v[4 * i + 3] = x[3];
  }
  __syncthreads();
  u32 lo = 0u, hi = 0x3F800001u;
  int it = 0;
  while (hi - lo > 1u) {
    const u32 mid = lo + ((hi - lo) >> 1);
    int c = 0;
#pragma unroll
    for (int i = 0; i < 128; ++i) c += (v[i] >= mid) ? 1 : 0;
#pragma unroll
    for (int o = 32; o >= 1; o >>= 1) c += __shfl_xor(c, o);
    const int par = it & 1;
    if (lane == 0) red[par * 8 + wid] = c;
    __syncthreads();
    int tot = 0;
#pragma unroll
    for (int w = 0; w < NWAV; ++w) tot += red[par * 8 + w];
    if (tot >= cap) lo = mid; else hi = mid;
    ++it;
  }
  const u32 thr = lo;
  int my_gt = 0, my_eq = 0;
#pragma unroll
  for (int i = 0; i < 128; ++i) { my_gt += (v[i] > thr) ? 1 : 0; my_eq += (v[i] == thr) ? 1 : 0; }
  int sg = my_gt, se = my_eq;
#pragma unroll
  for (int o = 1; o < 64; o <<= 1) {
    const int tg = __shfl_up(sg, o), te = __shfl_up(se, o);
    if (lane >= o) { sg += tg; se += te; }
  }
  __syncthreads();
  if (lane == 63) { scn[wid * 2] = sg; scn[wid * 2 + 1] = se; }
  __syncthreads();
  int base_gt = sg - my_gt, base_eq = se - my_eq, cnt_gt = 0;
#pragma unroll
  for (int w = 0; w < NWAV; ++w) {
    const int g_ = scn[w * 2], e_ = scn[w * 2 + 1];
    if (w < wid) { base_gt += g_; base_eq += e_; }
    cnt_gt += g_;
  }
  const int need = cap - cnt_gt;
#pragma unroll 1
  for (int i0 = 0; i0 < per; i0 += 16) {
    u32 w[16];
#pragma unroll
    for (int k = 0; k < 4; ++k) {
      const u32x4 x = *(const u32x4*)(a + tbeg + i0 + 4 * k);
      w[4 * k] = x[0]; w[4 * k + 1] = x[1]; w[4 * k + 2] = x[2]; w[4 * k + 3] = x[3];
    }
    int sl[16];
#pragma unroll
    for (int k = 0; k < 16; ++k) {
      const u32 u = w[k];
      int slot = -1;
      if (u > thr) slot = base_gt++;
      else if (u == thr) { const int r = base_eq++; if (r < need) slot = cnt_gt + r; }
      sl[k] = slot;
    }
#pragma unroll
    for (int k = 0; k < 16; ++k) {
      const int t = tbeg + i0 + k;
      if (sl[k] >= 0) { IDX[sl[k]] = t; GATE[sl[k]] = __uint_as_float(w[k]); }
      SEL[(size_t)t * 16 + e] = sl[k];
    }
  }
}

DI void phase_ln2(const Params& p, const GroupCtx& G, int layer, const u16* YE) {
  const int lane = TIDX() & 63, wid = TIDX() >> 6;
  const u16* X1 = (const u16*)(p.ws + OFF_R4);
  const int* SEL = (const int*)(p.ws + OFF_SEL);
  u16* XB = G.xb1;
  const float* gam = p.ln_ffn_g + layer * 1024;
  const float* bet = p.ln_ffn_b + layer * 1024;
  u32x4 nx1[2];
  int nsel = -1;
  auto ld_tok = [&](int t) {
    nx1[0] = *(const u32x4*)(X1 + (size_t)t * 1024 + lane * 8);
    nx1[1] = *(const u32x4*)(X1 + (size_t)t * 1024 + 512 + lane * 8);
    nsel = SEL[(size_t)t * 16 + (lane & 15)];
  };
  const int tstride = GDIM() * NWAV;
  int t = BIDX() * NWAV + wid;
  if (t < G.T) ld_tok(t);
  for (; t < G.T; t += tstride) {
    float v[16];
#pragma unroll
    for (int hh = 0; hh < 2; ++hh)
#pragma unroll
      for (int k = 0; k < 4; ++k) { v[hh * 8 + 2 * k] = DN_ALPHA_F * bflo(nx1[hh][k]); v[hh * 8 + 2 * k + 1] = DN_ALPHA_F * bfhi(nx1[hh][k]); }
    const int selv = nsel;
    if (t + tstride < G.T) ld_tok(t + tstride);
    unsigned msk = (unsigned)(__ballot(selv >= 0) & 0xffffull);
    while (msk) {
      int ee[4];
      u32x2 y[4][2];
#pragma unroll
      for (int k = 0; k < 4; ++k) {
        ee[k] = msk ? (__ffs(msk) - 1) : -1;
        if (msk) msk &= msk - 1;
      }
#pragma unroll
      for (int k = 0; k < 4; ++k) {
        if (ee[k] >= 0) {
          const int s = __shfl(selv, ee[k]);
          const u8* yp = (const u8*)YE + ((size_t)ee[k] * G.cap + s) * 1024;
          y[k][0] = *(const u32x2*)(yp + lane * 8);
          y[k][1] = *(const u32x2*)(yp + 512 + lane * 8);
        } else {
          y[k][0] = u32x2{0u, 0u}; y[k][1] = u32x2{0u, 0u};
        }
      }
#pragma unroll
      for (int k = 0; k < 4; ++k)
#pragma unroll
        for (int hh = 0; hh < 2; ++hh)
#pragma unroll
          for (int j = 0; j < 2; ++j) {
            const f32x2_t lo = __builtin_amdgcn_cvt_pk_f32_fp8((int)y[k][hh][j], false), hi = __builtin_amdgcn_cvt_pk_f32_fp8((int)y[k][hh][j], true);
            v[hh * 8 + 4 * j] += lo[0] * (1.0f / 64.0f); v[hh * 8 + 4 * j + 1] += lo[1] * (1.0f / 64.0f);
            v[hh * 8 + 4 * j + 2] += hi[0] * (1.0f / 64.0f); v[hh * 8 + 4 * j + 3] += hi[1] * (1.0f / 64.0f);
          }
    }
    float s = 0.f;
#pragma unroll
    for (int k = 0; k < 16; ++k) s += v[k];
    const float mean = wave_sum(s) * (1.0f / 1024.0f);
    float q = 0.f;
#pragma unroll
    for (int k = 0; k < 16; ++k) { const float d = v[k] - mean; q += d * d; }
    const float rstd = rsqrtf(wave_sum(q) * (1.0f / 1024.0f) + LN_EPS_F);
#pragma unroll
    for (int hh = 0; hh < 2; ++hh) {
      const int c = hh * 512 + lane * 8;
      const float4 g0 = *(const float4*)(gam + c), g1 = *(const float4*)(gam + c + 4);
      const float4 b0 = *(const float4*)(bet + c), b1 = *(const float4*)(bet + c + 4);
      const float gg[8] = {g0.x, g0.y, g0.z, g0.w, g1.x, g1.y, g1.z, g1.w};
      const float bb[8] = {b0.x, b0.y, b0.z, b0.w, b1.x, b1.y, b1.z, b1.w};
      float y[8];
#pragma unroll
      for (int k = 0; k < 8; ++k) y[k] = (v[hh * 8 + k] - mean) * rstd * gg[k] + bb[k];
      if (layer == 0) {
        u32x4 ov; ov[0] = pk(y[0], y[1]); ov[1] = pk(y[2], y[3]); ov[2] = pk(y[4], y[5]); ov[3] = pk(y[6], y[7]);
        *(u32x4*)(XB + (size_t)t * 1024 + c) = ov;
      } else {
        float* op = G.out + (size_t)t * 1024 + c;
        *(float4*)op = make_float4(y[0], y[1], y[2], y[3]);
        *(float4*)(op + 4) = make_float4(y[4], y[5], y[6], y[7]);
      }
    }
  }
}


#define XB_TMO      128
#define XB_XCNT(j)  (256  + 64 * (j))
#define XB_XSUB(j)  (1280 + 64 * (j))
#define XB_XGEN(j)  (2304 + 64 * (j))
#define XB_TOP      3328
#define XB_TOPGEN   3392
#define XCD_BAR_WORDS 3456
#define XB_SPIN_CAP (1u << 22)
DI unsigned xb_ld(unsigned* p)              { return __hip_atomic_load(p, __ATOMIC_RELAXED, __HIP_MEMORY_SCOPE_AGENT); }
DI unsigned xb_add(unsigned* p, unsigned v) { return __hip_atomic_fetch_add(p, v, __ATOMIC_RELAXED, __HIP_MEMORY_SCOPE_AGENT); }
DI unsigned xb_xcc_id() { return (unsigned)__builtin_amdgcn_s_getreg((3 << 11) | 20) & 0xFu; }
#define XB_SPIN(cond, bar) do { unsigned _sp = 0; while (cond) { __builtin_amdgcn_s_sleep(1); \
    if ((++_sp & 255u) == 0u) { if (xb_ld(&(bar)[XB_TMO])) break; if (_sp > XB_SPIN_CAP) { atomicAdd(&(bar)[XB_TMO], 1u); break; } } } } while (0)
struct XcdBarrier { unsigned* bar; unsigned x; volatile LAS unsigned* st; };
DI XcdBarrier xcd_barrier_post(unsigned* bar, volatile LAS unsigned* st) {
  XcdBarrier b; b.bar = bar; b.x = xb_xcc_id(); b.st = st;
  if (threadIdx.x == 0) (void)xb_add(&bar[XB_XCNT(b.x)], 1u);
  return b;
}
DI void xcd_barrier_complete(unsigned* bar, unsigned x, unsigned& nloc, unsigned& nx) {
  const unsigned G = gridDim.x * gridDim.y * gridDim.z;
  unsigned sum, cnt, mine, sp = 0u;
  for (;;) {
    sum = 0u; cnt = 0u; mine = 0u;
#pragma unroll
    for (unsigned j = 0; j < 16; ++j) { const unsigned c = xb_ld(&bar[XB_XCNT(j)]); sum += c; cnt += (c > 0u) ? 1u : 0u; mine = (j == x) ? c : mine; }
    if (sum == G) break;
    __builtin_amdgcn_s_sleep(1);
    if ((++sp & 255u) == 0u) { if (xb_ld(&bar[XB_TMO])) break; if (sp > XB_SPIN_CAP) { atomicAdd(&bar[XB_TMO], 1u); break; } }
  }
  nloc = mine > 0u ? mine : 1u; nx = cnt > 0u ? cnt : 1u;
}
DI void xcd_barrier(const XcdBarrier& b) {
  asm volatile("s_waitcnt vmcnt(0)" ::: "memory");
  __syncthreads();
  if (threadIdx.x == 0) {
    unsigned* bar = b.bar;
    __builtin_amdgcn_s_waitcnt(0);
    unsigned nloc = b.st[0], nx = b.st[1];
    if (nloc == 0u) { xcd_barrier_complete(bar, b.x, nloc, nx); b.st[0] = nloc; b.st[1] = nx; }
    const unsigned old = xb_add(&bar[XB_XSUB(b.x)], 1u);
    const unsigned gen = old / nloc;
    if (old + 1u == (gen + 1u) * nloc) {
      __builtin_amdgcn_fence(__ATOMIC_RELEASE, "agent");
      asm volatile("s_waitcnt vmcnt(0)" ::: "memory");
      const unsigned og = xb_add(&bar[XB_TOP], 1u);
      const unsigned tg = og / nx;
      if (og + 1u == (tg + 1u) * nx) xb_add(&bar[XB_TOPGEN], 1u);
      else XB_SPIN(xb_ld(&bar[XB_TOPGEN]) == tg, bar);
      __builtin_amdgcn_fence(__ATOMIC_ACQUIRE, "agent");
      xb_add(&bar[XB_XGEN(b.x)], 1u);
      asm volatile("s_waitcnt vmcnt(0)" ::: "memory");
    } else {
      XB_SPIN(xb_ld(&bar[XB_XGEN(b.x)]) == gen, bar);
      __builtin_amdgcn_fence(__ATOMIC_ACQUIRE, "agent");
      asm volatile("s_waitcnt vmcnt(0)" ::: "memory");
    }
  }
  __syncthreads();
}

DI void run_phase(const Params& p, int ph, char* smem) {
  if (ph == 0) { phase_prologue(p, smem); return; }
  int seg, s;
  if (ph <= 20) { seg = (ph - 1) / 10; s = (ph - 1) % 10; }
  else { seg = 2 + (ph - 21) / 9; s = 10 + (ph - 21) % 9; }
  const int g = seg & 1;
  GroupCtx G;
  float* out_p = p.out;
  float* out_s = p.out + (size_t)32768 * 1024;
  if (g == 0) { G.T = 32768; G.NB = 16; G.cap = 4096; G.xin = p.x_prompt; G.out = out_p; }
  else { G.T = 65536; G.NB = 32; G.cap = 8192; G.xin = p.x_sample; G.out = out_s; }
  G.xb1 = (g == 0) ? (u16*)out_p : (u16*)(p.ws + OFF_R2);
  G.p1 = (g == 0) ? ((u16*)out_p + (size_t)32768 * 1024) : (u16*)out_s;
  u16* YE0 = (u16*)out_s;
  u16* YE1 = (g == 0) ? (u16*)(p.ws + OFF_R3) : (u16*)(p.ws + OFF_R2);
  switch (s) {
    case 0: phase_conv0(p, G, smem); break;
    case 1: phase_gemm_in0(p, G, smem); break;
    case 2: phase_mix0(p, G, smem); break;
    case 3: phase_comb0(p, G); break;
    case 4: phase_gemm_out(p, G, 0, smem); break;
    case 5: phase_ln1(p, G, 0, smem); break;
    case 6: phase_sel(p, G, smem); break;
    case 7: phase_gemm_gu(p, G, smem); break;
    case 8: phase_gemm_dn(p, G, YE0, smem); break;
    case 9:
      phase_ln2(p, G, 0, YE0);
      if (g == 1) { for (int item = BIDX(); item < 3 * 5632 / 2; item += GDIM()) conv_moe_layer(p, 1, item, smem); }
      break;
    case 10: phase_gemm_in1(p, G, smem); break;
    case 11: phase_mix1(p, G, smem); break;
    case 12: phase_comb1(p, G); break;
    case 13: phase_gemm_out(p, G, 1, smem); break;
    case 14: phase_ln1(p, G, 1, smem); break;
    case 15: phase_sel(p, G, smem); break;
    case 16: phase_gemm_gu(p, G, smem); break;
    case 17: phase_gemm_dn(p, G, YE1, smem); break;
    case 18: phase_ln2(p, G, 1, YE1); break;
    default: break;
  }
}

#ifndef REPEAT_MASK
#define REPEAT_MASK 0
#endif
#ifndef DBG_STOP
#define DBG_STOP 0
#endif
#ifndef DBG_OFF
#define DBG_OFF OFF_R4
#endif
__global__ void __launch_bounds__(256, 2) dbg_dump(Params p) {
  const u16* src = (const u16*)(p.ws + DBG_OFF);
  const size_t n = (size_t)98304 * 1024, nsrc = (size_t)32768 * 1024;
  for (size_t i = (size_t)blockIdx.x * 256 + threadIdx.x; i < n; i += (size_t)gridDim.x * 256)
  {
    float v = (i < nsrc) ? __uint_as_float(((u32)src[i]) << 16) : 0.f;
    if (v != v) v = 1.0e6f; else if (fabsf(v) > 1.0e30f) v = 3.0e6f;
    p.out[i] = v;
  }
}
__global__ void __launch_bounds__(512) hybrid_mega(Params p, int ph_lo, int ph_hi) {
  extern __shared__ __attribute__((aligned(16))) char smem[];
  volatile LAS unsigned* xst = (volatile LAS unsigned*)((LAS char*)smem + (SMEM_BYTES - 16));
  if (threadIdx.x == 0) { xst[0] = 0u; xst[1] = 0u; }
  __syncthreads();
  const XcdBarrier xb = xcd_barrier_post((unsigned*)(p.ws + OFF_BAR), xst);
#pragma unroll 1
  for (int ph = ph_lo; ph < ph_hi; ++ph) {
    Params q = p;
#define LAUNDER(f) asm volatile("" : "+s"(q.f))
    LAUNDER(x_prompt); LAUNDER(x_sample); LAUNDER(even_w_in); LAUNDER(ml_gate_bias); LAUNDER(na_rpb); LAUNDER(ml_norm_g);
    LAUNDER(even_w_out); LAUNDER(da_w_in); LAUNDER(da_w_out); LAUNDER(ln_mix_g); LAUNDER(ln_mix_b); LAUNDER(ec_router);
    LAUNDER(ec_w_gate); LAUNDER(ec_w_up); LAUNDER(ec_w_down); LAUNDER(ln_ffn_g); LAUNDER(ln_ffn_b); LAUNDER(out); LAUNDER(ws);
#undef LAUNDER
    int reps = 1;
#if REPEAT_MASK
    if (ph > 0 && ((REPEAT_MASK >> (ph % 32)) & 1)) reps = 2;
#endif
#pragma unroll 1
    for (int rr = 0; rr < reps; ++rr) {
      if (rr) xcd_barrier(xb);
      run_phase(q, ph, smem);
    }
    if (ph + 1 < ph_hi) { if (ph_lo < 0) cg::this_grid().sync(); else xcd_barrier(xb); }
  }
}

extern "C" void kernel_launch(void* const* d_in, const int* in_sizes, int n_in, void* d_out, int out_size,
                              void* d_ws, size_t ws_size, hipStream_t stream) {
  (void)in_sizes; (void)n_in; (void)out_size;
  Params p;
  memset(&p, 0, sizeof(p));
  p.x_prompt = (const float*)d_in[0];   p.x_sample = (const float*)d_in[1];
  p.even_w_in = (const float*)d_in[2];  p.ml_gate_bias = (const float*)d_in[3];
  p.na_rpb = (const float*)d_in[4];     p.ml_norm_g = (const float*)d_in[5];
  p.even_w_out = (const float*)d_in[6]; p.da_w_in = (const float*)d_in[7];
  p.da_w_out = (const float*)d_in[8];   p.ln_mix_g = (const float*)d_in[9];
  p.ln_mix_b = (const float*)d_in[10];  p.ec_router = (const float*)d_in[11];
  p.ec_w_gate = (const float*)d_in[12]; p.ec_w_up = (const float*)d_in[13];
  p.ec_w_down = (const float*)d_in[14]; p.ln_ffn_g = (const float*)d_in[15];
  p.ln_ffn_b = (const float*)d_in[16];
  p.out = (float*)d_out;
  p.ws = (char*)d_ws;
  if (ws_size < WS_NEEDED) { fprintf(stderr, "workspace too small: %zu < %zu\n", ws_size, (size_t)WS_NEEDED); return; }
  static int grid_blocks = 0;
  if (!grid_blocks) {
    int dev = 0, cus = 0, per_cu = 0;
    hipGetDevice(&dev);
    hipDeviceGetAttribute(&cus, hipDeviceAttributeMultiprocessorCount, dev);
    hipFuncSetAttribute((const void*)hybrid_mega, hipFuncAttributeMaxDynamicSharedMemorySize, SMEM_BYTES);
    hipOccupancyMaxActiveBlocksPerMultiprocessor(&per_cu, hybrid_mega, NTHR, SMEM_BYTES);
    if (per_cu < 1) per_cu = 1;
    if (per_cu > 1) per_cu = 1;
    grid_blocks = cus * per_cu;
  }
  hipMemsetAsync((char*)d_ws + OFF_BAR, 0, XCD_BAR_WORDS * 4, stream);
#if MULTI_LAUNCH
  for (int ph = 0; ph < (DBG_STOP ? DBG_STOP : NPHASES); ++ph) {
    hipLaunchKernelGGL(hybrid_mega, dim3(grid_blocks), dim3(NTHR), SMEM_BYTES, stream, p, ph, ph + 1);
  }
  if (DBG_STOP) hipLaunchKernelGGL(dbg_dump, dim3(grid_blocks), dim3(256), 0, stream, p);
#else
  int lo = 0, hi = NPHASES;
  void* args[] = {&p, &lo, &hi};
  hipError_t e = hipLaunchCooperativeKernel((void*)hybrid_mega, dim3(grid_blocks), dim3(NTHR), args, SMEM_BYTES, stream);
  if (e != hipSuccess) fprintf(stderr, "cooperative launch failed: %s (grid %d)\n", hipGetErrorString(e), grid_blocks);
#endif
}
```

```cpp
#include <hip/hip_runtime.h>
#include <hip/hip_cooperative_groups.h>
#include <cstdio>
#include <cstring>
namespace cg = cooperative_groups;

#ifndef MULTI_LAUNCH
#define MULTI_LAUNCH 0
#endif

typedef unsigned short u16;
typedef unsigned int u32;
using bf16x8 = __attribute__((ext_vector_type(8))) short;
using s16x4 = __attribute__((ext_vector_type(4))) short;
using f32x4 = __attribute__((ext_vector_type(4))) float;
using u32x4 = __attribute__((ext_vector_type(4))) unsigned;
using u32x2 = __attribute__((ext_vector_type(2))) unsigned;

#define DI __device__ __forceinline__
#define MFMA(a, b, c) __builtin_amdgcn_mfma_f32_16x16x32_bf16((a), (b), (c), 0, 0, 0)

constexpr int NPH_G = 19;
constexpr int NPHASES = 1 + 2 * 10 + 2 * 9;
constexpr int SMEM_BYTES = 155648;
constexpr int NTHR = 512;
constexpr int NWAV = 8;
#define LAS __attribute__((address_space(3)))
constexpr float DN_ALPHA_F = 1.41421356237309515f;
constexpr float LN_EPS_F = 1e-5f;

constexpr size_t OFF_WIN = 0;
constexpr size_t OFF_WOE = OFF_WIN + 7864320;
constexpr size_t OFF_WQKV = OFF_WOE + 2097152;
constexpr size_t OFF_WOO = OFF_WQKV + 6291456;
constexpr size_t OFF_ROPE = OFF_WOO + 2097152;
constexpr size_t OFF_WGU = OFF_ROPE + 524288;
constexpr size_t OFF_WDN = OFF_WGU + 92274688;
constexpr size_t OFF_AFF = OFF_WDN + 46137344;
constexpr size_t OFF_IDX = OFF_AFF + 4194304;
constexpr size_t OFF_GATE = OFF_IDX + 524288;
constexpr size_t OFF_SEL = OFF_GATE + 524288;
constexpr size_t OFF_GATES = OFF_SEL + 4194304;
constexpr size_t OFF_R1 = OFF_GATES + 4194304;
constexpr size_t OFF_X1Q = OFF_R1 + 201326592;
constexpr size_t OFF_R2 = OFF_R1 + 469762048;
constexpr size_t OFF_R3 = OFF_R2 + 134217728;
constexpr size_t OFF_R4 = OFF_R3 + 134217728;
constexpr size_t OFF_BAR = OFF_R4 + 134217728;
constexpr size_t WS_NEEDED = OFF_BAR + 16384;

struct Params {
  const float *x_prompt, *x_sample, *even_w_in, *ml_gate_bias, *na_rpb, *ml_norm_g, *even_w_out, *da_w_in, *da_w_out;
  const float *ln_mix_g, *ln_mix_b, *ec_router, *ec_w_gate, *ec_w_up, *ec_w_down, *ln_ffn_g, *ln_ffn_b;
  float* out;
  char* ws;
};

struct GroupCtx {
  int T, NB, cap;
  const float* xin;
  float* out;
  u16* xb1;
  u16* p1;
};

DI int TIDX() { int t = threadIdx.x; asm volatile("" : "+v"(t)); return t; }
DI int BIDX() { int t = blockIdx.x; asm volatile("" : "+s"(t)); return t; }
DI int GDIM() { int t = gridDim.x; asm volatile("" : "+s"(t)); return t; }
typedef float f32x2_t __attribute__((ext_vector_type(2)));
typedef __bf16 bf16x2_t __attribute__((ext_vector_type(2)));
DI u32 pk(float lo, float hi) { f32x2_t v = {lo, hi}; bf16x2_t b = __builtin_convertvector(v, bf16x2_t); return __builtin_bit_cast(u32, b); }
DI float bflo(u32 w) { return __uint_as_float(w << 16); }
DI float bfhi(u32 w) { return __uint_as_float(w & 0xffff0000u); }
DI bf16x8 ld8(const u16* p) { return *reinterpret_cast<const bf16x8*>(p); }
DI bf16x8 tr_read2(unsigned a0, unsigned a1) {
  s16x4 x, y;
  asm volatile("ds_read_b64_tr_b16 %0, %2\n\tds_read_b64_tr_b16 %1, %3\n\ts_waitcnt lgkmcnt(0)"
               : "=&v"(x), "=&v"(y) : "v"(a0), "v"(a1) : "memory");
  return __builtin_shufflevector(x, y, 0, 1, 2, 3, 4, 5, 6, 7);
}
DI void tr_read_4x2(unsigned base, bf16x8 (&out)[4]) {
  s16x4 x0, y0, x1, y1, x2, y2, x3, y3;
  asm volatile("ds_read_b64_tr_b16 %0, %8\n\t"
               "ds_read_b64_tr_b16 %1, %8 offset:2304\n\t"
               "ds_read_b64_tr_b16 %2, %8 offset:32\n\t"
               "ds_read_b64_tr_b16 %3, %8 offset:2336\n\t"
               "ds_read_b64_tr_b16 %4, %8 offset:64\n\t"
               "ds_read_b64_tr_b16 %5, %8 offset:2368\n\t"
               "ds_read_b64_tr_b16 %6, %8 offset:96\n\t"
               "ds_read_b64_tr_b16 %7, %8 offset:2400\n\t"
               "s_waitcnt lgkmcnt(0)"
               : "=&v"(x0), "=&v"(y0), "=&v"(x1), "=&v"(y1), "=&v"(x2), "=&v"(y2), "=&v"(x3), "=&v"(y3)
               : "v"(base) : "memory");
  out[0] = __builtin_shufflevector(x0, y0, 0, 1, 2, 3, 4, 5, 6, 7);
  out[1] = __builtin_shufflevector(x1, y1, 0, 1, 2, 3, 4, 5, 6, 7);
  out[2] = __builtin_shufflevector(x2, y2, 0, 1, 2, 3, 4, 5, 6, 7);
  out[3] = __builtin_shufflevector(x3, y3, 0, 1, 2, 3, 4, 5, 6, 7);
}
DI void tr_read_8x2(unsigned b0, unsigned b1, bf16x8 (&out)[8]) {
  s16x4 x0, y0, x1, y1, x2, y2, x3, y3, x4, y4, x5, y5, x6, y6, x7, y7;
  asm volatile("ds_read_b64_tr_b16 %0, %16\n\t"
               "ds_read_b64_tr_b16 %1, %16 offset:2304\n\t"
               "ds_read_b64_tr_b16 %2, %16 offset:32\n\t"
               "ds_read_b64_tr_b16 %3, %16 offset:2336\n\t"
               "ds_read_b64_tr_b16 %4, %16 offset:64\n\t"
               "ds_read_b64_tr_b16 %5, %16 offset:2368\n\t"
               "ds_read_b64_tr_b16 %6, %16 offset:96\n\t"
               "ds_read_b64_tr_b16 %7, %16 offset:2400\n\t"
               "ds_read_b64_tr_b16 %8, %17\n\t"
               "ds_read_b64_tr_b16 %9, %17 offset:2304\n\t"
               "ds_read_b64_tr_b16 %10, %17 offset:32\n\t"
               "ds_read_b64_tr_b16 %11, %17 offset:2336\n\t"
               "ds_read_b64_tr_b16 %12, %17 offset:64\n\t"
               "ds_read_b64_tr_b16 %13, %17 offset:2368\n\t"
               "ds_read_b64_tr_b16 %14, %17 offset:96\n\t"
               "ds_read_b64_tr_b16 %15, %17 offset:2400\n\t"
               "s_waitcnt lgkmcnt(0)"
               : "=&v"(x0), "=&v"(y0), "=&v"(x1), "=&v"(y1), "=&v"(x2), "=&v"(y2), "=&v"(x3), "=&v"(y3),
                 "=&v"(x4), "=&v"(y4), "=&v"(x5), "=&v"(y5), "=&v"(x6), "=&v"(y6), "=&v"(x7), "=&v"(y7)
               : "v"(b0), "v"(b1) : "memory");
  out[0] = __builtin_shufflevector(x0, y0, 0, 1, 2, 3, 4, 5, 6, 7);
  out[1] = __builtin_shufflevector(x1, y1, 0, 1, 2, 3, 4, 5, 6, 7);
  out[2] = __builtin_shufflevector(x2, y2, 0, 1, 2, 3, 4, 5, 6, 7);
  out[3] = __builtin_shufflevector(x3, y3, 0, 1, 2, 3, 4, 5, 6, 7);
  out[4] = __builtin_shufflevector(x4, y4, 0, 1, 2, 3, 4, 5, 6, 7);
  out[5] = __builtin_shufflevector(x5, y5, 0, 1, 2, 3, 4, 5, 6, 7);
  out[6] = __builtin_shufflevector(x6, y6, 0, 1, 2, 3, 4, 5, 6, 7);
  out[7] = __builtin_shufflevector(x7, y7, 0, 1, 2, 3, 4, 5, 6, 7);
}
DI bf16x8 pack8(f32x4 a, f32x4 b) {
  u32x4 r; r[0] = pk(a[0], a[1]); r[1] = pk(a[2], a[3]); r[2] = pk(b[0], b[1]); r[3] = pk(b[2], b[3]);
  return __builtin_bit_cast(bf16x8, r);
}
DI float wave_sum(float v) {
#pragma unroll
  for (int o = 32; o >= 1; o >>= 1) v += __shfl_xor(v, o);
  return v;
}

DI int VBID() { const int b = BIDX(), g = GDIM(); return (g & 7) ? b : (b & 7) * (g >> 3) + (b >> 3); }
DI void tile_decode(int item, int NT, int& mt, int& nt) { const int mg = item / (NT * 8), rem = item - mg * (NT * 8); nt = rem >> 3; mt = mg * 8 + (rem & 7); }

template <bool GATHER>
DI void gemm_tile(const u16* __restrict__ A, int lda, const int* __restrict__ ridx, int row0,
                  const u16* __restrict__ Bt, int ldb, int col0, int K, f32x4 (&acc)[8][4], char* smem) {
  const int tid = TIDX(), lane = tid & 63, wid = tid >> 6, wr = wid >> 2, wc = wid & 3, fr = lane & 15, fq = lane >> 4;
  const int r0 = tid >> 3, pc = tid & 7;
  const int c = pc ^ ((r0 >> 1) & 7);
  unsigned pa[4];
#pragma unroll
  for (int i = 0; i < 4; ++i) {
    const int r = r0 + 64 * i;
    if (GATHER) pa[i] = (unsigned)ridx[row0 + r] * (unsigned)lda + c * 8;
    else pa[i] = (unsigned)(row0 + r) * (unsigned)lda + c * 8;
  }
  const u16* pb0 = Bt + (size_t)(col0 + r0) * ldb + c * 8;
  const size_t sb64 = (size_t)64 * ldb;
#pragma unroll
  for (int m = 0; m < 8; ++m)
#pragma unroll
    for (int n = 0; n < 4; ++n) acc[m][n] = f32x4{0.f, 0.f, 0.f, 0.f};
  const int key = (fr >> 1) & 7;
  const int p0 = (fq ^ key) * 16, p1 = ((fq ^ key) ^ 4) * 16;
  const char* rA = smem + (wr * 128 + fr) * 128;
  const char* rB = smem + 65536 + (wc * 64 + fr) * 128;
  LAS char* lds = (LAS char*)smem;
  const int wofs = tid * 16;
  const int nk = K >> 6;
#define G_STAGE(buf_, kt_) { const int ko_ = (kt_) * 64; _Pragma("unroll") for (int i = 0; i < 4; ++i) { \
      __builtin_amdgcn_global_load_lds((const unsigned*)(A + (size_t)pa[i] + ko_), (LAS unsigned*)(lds + (buf_) * 32768 + wofs + i * 8192), 16, 0, 0); \
      __builtin_amdgcn_global_load_lds((const unsigned*)(pb0 + i * sb64 + ko_), (LAS unsigned*)(lds + 65536 + (buf_) * 32768 + wofs + i * 8192), 16, 0, 0); } }
  __syncthreads();
  G_STAGE(0, 0);
  asm volatile("s_waitcnt vmcnt(0)" ::: "memory");
  __syncthreads();
  for (int kt = 0; kt < nk; ++kt) {
    const int cur = kt & 1;
    if (kt + 1 < nk) G_STAGE(cur ^ 1, kt + 1);
    const char* cA = rA + cur * 32768;
    const char* cB = rB + cur * 32768;
#pragma unroll
    for (int ks = 0; ks < 2; ++ks) {
      const int po = ks ? p1 : p0;
      bf16x8 bf[4];
#pragma unroll
      for (int n = 0; n < 4; ++n) bf[n] = *(const bf16x8*)(cB + n * 2048 + po);
#pragma unroll
      for (int mh = 0; mh < 2; ++mh) {
        bf16x8 af[4];
#pragma unroll
        for (int m = 0; m < 4; ++m) af[m] = *(const bf16x8*)(cA + (mh * 4 + m) * 2048 + po);
#pragma unroll
        for (int m = 0; m < 4; ++m)
#pragma unroll
          for (int n = 0; n < 4; ++n) acc[mh * 4 + m][n] = MFMA(bf[n], af[m], acc[mh * 4 + m][n]);
      }
    }
    asm volatile("s_waitcnt vmcnt(0)" ::: "memory");
    __syncthreads();
  }
#undef G_STAGE
}

typedef unsigned char u8;
DI u32 pk4_fp8(float a, float b, float c, float d) {
  int w = __builtin_amdgcn_cvt_pk_fp8_f32(a, b, 0, false);
  w = __builtin_amdgcn_cvt_pk_fp8_f32(c, d, w, true);
  return (u32)w;
}
template <bool GATHER>
DI void gemm_tile_fp8(const u8* __restrict__ A, int lda, const int* __restrict__ ridx, int row0, const u8* __restrict__ Bt, int ldb, int col0, int K,
                      f32x4 (&acc)[8][4], char* smem) {
  const int tid = TIDX(), lane = tid & 63, wid = tid >> 6, wr = wid >> 2, wc = wid & 3, fr = lane & 15, fq = lane >> 4;
  const int r0 = tid >> 3, pc = tid & 7;
  const int c = pc ^ ((r0 >> 1) & 7);
  unsigned pa[4];
#pragma unroll
  for (int i = 0; i < 4; ++i) pa[i] = (GATHER ? (unsigned)ridx[row0 + r0 + 64 * i] : (unsigned)(row0 + r0 + 64 * i)) * (unsigned)lda + c * 16;
  const u8* pb0 = Bt + (size_t)(col0 + r0) * ldb + c * 16;
  const size_t sb64 = (size_t)64 * ldb;
#pragma unroll
  for (int m = 0; m < 8; ++m)
#pragma unroll
    for (int n = 0; n < 4; ++n) acc[m][n] = f32x4{0.f, 0.f, 0.f, 0.f};
  const int key = (fr >> 1) & 7;
  const char* rA = smem + (wr * 128 + fr) * 128;
  const char* rB = smem + 65536 + (wc * 64 + fr) * 128;
  LAS char* lds = (LAS char*)smem;
  const int wofs = tid * 16;
  const int nk = K >> 7;
#define G8_STAGE(buf_, kt_) { const int ko_ = (kt_) * 128; _Pragma("unroll") for (int i = 0; i < 4; ++i) { \
      __builtin_amdgcn_global_load_lds((const unsigned*)(A + (size_t)pa[i] + ko_), (LAS unsigned*)(lds + (buf_) * 32768 + wofs + i * 8192), 16, 0, 0); \
      __builtin_amdgcn_global_load_lds((const unsigned*)(pb0 + i * sb64 + ko_), (LAS unsigned*)(lds + 65536 + (buf_) * 32768 + wofs + i * 8192), 16, 0, 0); } }
  __syncthreads();
  G8_STAGE(0, 0);
  asm volatile("s_waitcnt vmcnt(0)" ::: "memory");
  __syncthreads();
  for (int kt = 0; kt < nk; ++kt) {
    const int cur = kt & 1;
    if (kt + 1 < nk) G8_STAGE(cur ^ 1, kt + 1);
    const char* cA = rA + cur * 32768;
    const char* cB = rB + cur * 32768;
    typedef long long2_t __attribute__((ext_vector_type(2)));
#pragma unroll
    for (int jp = 0; jp < 2; ++jp) {
      const int po = ((4 * jp + fq) ^ key) * 16;
      long2_t bf[4];
#pragma unroll
      for (int n = 0; n < 4; ++n) bf[n] = *(const long2_t*)(cB + n * 2048 + po);
#pragma unroll
      for (int mh = 0; mh < 2; ++mh) {
        long2_t af[4];
#pragma unroll
        for (int m = 0; m < 4; ++m) af[m] = *(const long2_t*)(cA + (mh * 4 + m) * 2048 + po);
#pragma unroll
        for (int m = 0; m < 4; ++m)
#pragma unroll
          for (int n = 0; n < 4; ++n) {
            acc[mh * 4 + m][n] = __builtin_amdgcn_mfma_f32_16x16x32_fp8_fp8(bf[n][0], af[m][0], acc[mh * 4 + m][n], 0, 0, 0);
            acc[mh * 4 + m][n] = __builtin_amdgcn_mfma_f32_16x16x32_fp8_fp8(bf[n][1], af[m][1], acc[mh * 4 + m][n], 0, 0, 0);
          }
      }
    }
    asm volatile("s_waitcnt vmcnt(0)" ::: "memory");
    __syncthreads();
  }
#undef G8_STAGE
}

DI void conv_tile_fp8(const float* __restrict__ src, int N, int ldsrc, u8* __restrict__ dst, int lddst,
                      int k0, int n0, float scale, int mode, char* smem) {
  const int tid = TIDX() & 255;
  float* t = (float*)smem + (TIDX() >> 8) * 4160;
  __syncthreads();
#pragma unroll
  for (int i = 0; i < 4; ++i) {
    const int k = (tid >> 4) + 16 * i, n = (tid & 15) * 4;
    float4 v = make_float4(0.f, 0.f, 0.f, 0.f);
    if (n0 + n < N) v = *(const float4*)(src + (size_t)(k0 + k) * ldsrc + n0 + n);
    float* d = t + k * 65 + n;
    d[0] = v.x * scale; d[1] = v.y * scale; d[2] = v.z * scale; d[3] = v.w * scale;
  }
  __syncthreads();
#pragma unroll
  for (int i = 0; i < 2; ++i) {
    const int pidx = tid + 256 * i, n = pidx >> 3, kc = (pidx & 7) * 8;
    u32x2 o;
    o[0] = pk4_fp8(t[(kc + 0) * 65 + n], t[(kc + 1) * 65 + n], t[(kc + 2) * 65 + n], t[(kc + 3) * 65 + n]);
    o[1] = pk4_fp8(t[(kc + 4) * 65 + n], t[(kc + 5) * 65 + n], t[(kc + 6) * 65 + n], t[(kc + 7) * 65 + n]);
    const int nn = n0 + n;
    const int row = (mode == 0) ? nn : ((nn >> 5) * 64 + (nn & 31) + (mode == 2 ? 32 : 0));
    *(u32x2*)(dst + (size_t)row * lddst + k0 + kc) = o;
  }
}

DI void conv_tile(const float* __restrict__ src, int N, int ldsrc, u16* __restrict__ dst, int lddst,
                  int k0, int n0, int mode, char* smem) {
  const int tid = TIDX() & 255;
  float* t = (float*)smem + (TIDX() >> 8) * 4160;
  __syncthreads();
#pragma unroll
  for (int i = 0; i < 4; ++i) {
    const int k = (tid >> 4) + 16 * i, n = (tid & 15) * 4;
    float4 v = make_float4(0.f, 0.f, 0.f, 0.f);
    if (n0 + n < N) v = *(const float4*)(src + (size_t)(k0 + k) * ldsrc + n0 + n);
    float* d = t + k * 65 + n;
    d[0] = v.x; d[1] = v.y; d[2] = v.z; d[3] = v.w;
  }
  __syncthreads();
#pragma unroll
  for (int i = 0; i < 2; ++i) {
    const int pidx = tid + 256 * i, n = pidx >> 3, kc = (pidx & 7) * 8;
    u32x4 o;
    o[0] = pk(t[(kc + 0) * 65 + n], t[(kc + 1) * 65 + n]);
    o[1] = pk(t[(kc + 2) * 65 + n], t[(kc + 3) * 65 + n]);
    o[2] = pk(t[(kc + 4) * 65 + n], t[(kc + 5) * 65 + n]);
    o[3] = pk(t[(kc + 6) * 65 + n], t[(kc + 7) * 65 + n]);
    const int nn = n0 + n;
    const int row = (mode == 0) ? nn : ((nn >> 5) * 64 + (nn & 31) + (mode == 2 ? 32 : 0));
    *(u32x4*)(dst + (size_t)row * lddst + k0 + kc) = o;
  }
}

DI void conv_matrix_items(const float* src, int K, int N, int Npad, u16* dst, int mode, int item, char* smem) {
  const int ntn = Npad >> 6;
  const int kt = item / ntn, nt = item % ntn;
  conv_tile(src, N, N, dst, K, kt * 64, nt * 64, mode, smem);
}

DI void conv_moe_layer(const Params& p, int layer, int item, char* smem) {
  item = 2 * item + (TIDX() >> 8);
  const int which = item / 5632, r = item % 5632;
  const int e = r / 352, tl = r % 352;
  u16* WGU = (u16*)(p.ws + OFF_WGU);
  u16* WDN = (u16*)(p.ws + OFF_WDN);
  const size_t eo = ((size_t)layer * 16 + e) * (size_t)(1024 * 1408);
  if (which == 0) {
    conv_tile_fp8(p.ec_w_gate + eo, 1408, 1408, (u8*)WGU + (size_t)e * 2816 * 1024, 1024, (tl / 22) * 64, (tl % 22) * 64, 64.0f, 1, smem);
  } else if (which == 1) {
    conv_tile_fp8(p.ec_w_up + eo, 1408, 1408, (u8*)WGU + (size_t)e * 2816 * 1024, 1024, (tl / 22) * 64, (tl % 22) * 64, 64.0f, 2, smem);
  } else {
    { const int kt_ = tl / 16, nt_ = tl % 16;
      conv_tile_fp8(p.ec_w_down + eo, 1024, 1024, (u8*)WDN + (size_t)e * 1024 * 1408, 1408, kt_ * 64, nt_ * 64, 128.0f, 0, smem); }
  }
}

DI void phase_prologue(const Params& p, char* smem) {
  const int npairs = (960 + 256 + 768 + 256) / 2;
  for (int pr = BIDX(); pr < npairs; pr += GDIM()) {
    const int item = 2 * pr + (TIDX() >> 8);
    if (item < 960) conv_matrix_items(p.even_w_in, 1024, 3600, 3840, (u16*)(p.ws + OFF_WIN), 0, item, smem);
    else if (item < 1216) conv_matrix_items(p.even_w_out, 1024, 1024, 1024, (u16*)(p.ws + OFF_WOE), 0, item - 960, smem);
    else if (item < 1984) conv_matrix_items(p.da_w_in, 1024, 3072, 3072, (u16*)(p.ws + OFF_WQKV), 0, item - 1216, smem);
    else conv_matrix_items(p.da_w_out, 1024, 1024, 1024, (u16*)(p.ws + OFF_WOO), 0, item - 1984, smem);
  }
  for (int item = BIDX(); item < 3 * 5632 / 2; item += GDIM()) conv_moe_layer(p, 0, item, smem);
  float2* rope = (float2*)(p.ws + OFF_ROPE);
  for (int i = BIDX() * NTHR + TIDX(); i < 2048 * 32; i += GDIM() * NTHR) {
    const int pos = i >> 5, d = i & 31;
    const float inv = powf(10000.0f, -(float)(2 * d) / 64.0f);
    const float ang = (float)pos * inv;
    const double a = (double)ang;
    const double kk = rint(a * 0.15915494309189535);
    const float r = (float)(a - kk * 6.283185307179586);
    rope[i] = make_float2(__cosf(r), __sinf(r));
  }
}

DI void phase_conv0(const Params& p, const GroupCtx& G, char* smem) {
  u16* XB = (u16*)(p.ws + OFF_R2);
  const size_t n8 = (size_t)G.T * 128;
  for (size_t i = (size_t)BIDX() * NTHR + TIDX(); i < n8; i += (size_t)GDIM() * NTHR) {
    const float4 a = *(const float4*)(G.xin + i * 8), b = *(const float4*)(G.xin + i * 8 + 4);
    u32x4 o; o[0] = pk(a.x, a.y); o[1] = pk(a.z, a.w); o[2] = pk(b.x, b.y); o[3] = pk(b.z, b.w);
    *(u32x4*)(XB + i * 8) = o;
  }
}

DI void phase_gemm_in0(const Params& p, const GroupCtx& G, char* smem) {
  const u16* XB = (const u16*)(p.ws + OFF_R2);
  const u16* W = (const u16*)(p.ws + OFF_WIN);
  u16* PROJ = (u16*)(p.ws + OFF_R1);
  float* GATES = (float*)(p.ws + OFF_GATES);
  const int lane = TIDX() & 63, wid = TIDX() >> 6, wr = wid >> 2, wc = wid & 3, fr = lane & 15, fq = lane >> 4;
  const int nitems = (G.T >> 8) * 15;
  for (int item = VBID(); item < nitems; item += GDIM()) {
    int mt, nt; tile_decode(item, 15, mt, nt);
    f32x4 acc[8][4];
    gemm_tile<false>(XB, 1024, nullptr, mt * 256, W, 1024, nt * 256, 1024, acc, smem);
#pragma unroll
    for (int m = 0; m < 8; ++m) {
      const size_t row = (size_t)mt * 256 + wr * 128 + m * 16 + fr;
#pragma unroll
      for (int n = 0; n < 4; ++n) {
        const int col = nt * 256 + wc * 64 + n * 16 + 4 * fq;
        if (col < 3584) {
          u32x2 o; o[0] = pk(acc[m][n][0], acc[m][n][1]); o[1] = pk(acc[m][n][2], acc[m][n][3]);
          *(u32x2*)(PROJ + row * 3584 + col) = o;
        } else if (col < 3600) {
          const int c = col - 3584;
          f32x4 o;
#pragma unroll
          for (int j = 0; j < 4; ++j) o[j] = acc[m][n][j] + p.ml_gate_bias[c + j];
          *(f32x4*)(GATES + row * 16 + c) = o;
        }
      }
    }
  }
}

DI void phase_gemm_in1(const Params& p, const GroupCtx& G, char* smem) {
  const u16* XB = G.xb1;
  const u16* W = (const u16*)(p.ws + OFF_WQKV);
  u16* QKV = (u16*)(p.ws + OFF_R1);
  const float* rope = (const float*)(p.ws + OFF_ROPE);
  const int lane = TIDX() & 63, wid = TIDX() >> 6, wr = wid >> 2, wc = wid & 3, fr = lane & 15, fq = lane >> 4;
  const int nitems = (G.T >> 8) * 12;
  for (int item = VBID(); item < nitems; item += GDIM()) {
    int mt, nt; tile_decode(item, 12, mt, nt);
    f32x4 acc[8][4];
    gemm_tile<false>(XB, 1024, nullptr, mt * 256, W, 1024, nt * 256, 1024, acc, smem);
    const int cbase = nt * 256 + wc * 64;
    const int sec = cbase >> 10;
#pragma unroll
    for (int m = 0; m < 8; ++m) {
      const size_t row = (size_t)mt * 256 + wr * 128 + m * 16 + fr;
      if (sec < 2) {
        const int pos = (int)(row & 2047);
        const float sc = (sec == 0) ? 0.125f : 1.0f;
#pragma unroll
        for (int n = 0; n < 2; ++n) {
          const int d = n * 16 + 4 * fq;
          const float* rp = rope + ((size_t)pos * 32 + d) * 2;
          const f32x4 cs0 = *(const f32x4*)rp, cs1 = *(const f32x4*)(rp + 4);
          const float c[4] = {cs0[0], cs0[2], cs1[0], cs1[2]};
          const float s[4] = {cs0[1], cs0[3], cs1[1], cs1[3]};
          f32x4 o1, o2;
#pragma unroll
          for (int j = 0; j < 4; ++j) {
            const float x1 = acc[m][n][j], x2 = acc[m][n + 2][j];
            o1[j] = (x1 * c[j] - x2 * s[j]) * sc;
            o2[j] = (x1 * s[j] + x2 * c[j]) * sc;
          }
          acc[m][n] = o1; acc[m][n + 2] = o2;
        }
      }
#pragma unroll
      for (int n = 0; n < 4; ++n) {
        const int col = cbase + n * 16 + 4 * fq;
        u32x2 o; o[0] = pk(acc[m][n][0], acc[m][n][1]); o[1] = pk(acc[m][n][2], acc[m][n][3]);
        *(u32x2*)(QKV + row * 3072 + col) = o;
      }
    }
  }
}

DI void phase_gemm_out(const Params& p, const GroupCtx& G, int layer, char* smem) {
  const u16* Y = (const u16*)(p.ws + OFF_R3);
  const u16* W = (const u16*)(p.ws + (layer == 0 ? OFF_WOE : OFF_WOO));
  u16* MIX = (u16*)(p.ws + OFF_R1);
  const int lane = TIDX() & 63, wid = TIDX() >> 6, wr = wid >> 2, wc = wid & 3, fr = lane & 15, fq = lane >> 4;
  const int nitems = (G.T >> 8) * 4;
  for (int item = VBID(); item < nitems; item += GDIM()) {
    int mt, nt; tile_decode(item, 4, mt, nt);
    f32x4 acc[8][4];
    gemm_tile<false>(Y, 1024, nullptr, mt * 256, W, 1024, nt * 256, 1024, acc, smem);
#pragma unroll
    for (int m = 0; m < 8; ++m) {
      const size_t row = (size_t)mt * 256 + wr * 128 + m * 16 + fr;
#pragma unroll
      for (int n = 0; n < 4; ++n) {
        const int col = nt * 256 + wc * 64 + n * 16 + 4 * fq;
        u32x2 o; o[0] = pk(acc[m][n][0], acc[m][n][1]); o[1] = pk(acc[m][n][2], acc[m][n][3]);
        *(u32x2*)(MIX + row * 1024 + col) = o;
      }
    }
  }
}

DI void phase_gemm_gu(const Params& p, const GroupCtx& G, char* smem) {
  const u8* X1 = (const u8*)(p.ws + OFF_X1Q);
  const u8* WGU = (const u8*)(p.ws + OFF_WGU);
  const int* IDX = (const int*)(p.ws + OFF_IDX);
  u8* H = (u8*)(p.ws + OFF_R1);
  const int MT = G.cap >> 8;
  const int nitems = 16 * MT * 11;
  for (int item = VBID(); item < nitems; item += GDIM()) {
    const int e = item / (MT * 11); int mt, nt; tile_decode(item - e * (MT * 11), 11, mt, nt);
    f32x4 acc[8][4];
    gemm_tile_fp8<true>(X1, 1024, IDX + e * G.cap, mt * 256, WGU + (size_t)e * 2816 * 1024, 1024, nt * 256, 1024, acc, smem);
    const int lane = TIDX() & 63, wid = TIDX() >> 6, wr = wid >> 2, wc = wid & 3, fr = lane & 15, fq = lane >> 4;
#pragma unroll
    for (int m = 0; m < 8; ++m) {
      const size_t row = (size_t)e * G.cap + mt * 256 + wr * 128 + m * 16 + fr;
#pragma unroll
      for (int n = 0; n < 2; ++n) {
        const int f = (nt * 4 + wc) * 32 + n * 16 + 4 * fq;
        float hv[4];
#pragma unroll
        for (int j = 0; j < 4; ++j) {
          const float g = acc[m][n][j] * (1.0f / 64.0f), u = acc[m][n + 2][j] * (1.0f / 64.0f);
          hv[j] = g / (1.0f + __expf(-g)) * u;
        }
        *(u32*)(H + row * 1408 + f) = pk4_fp8(hv[0], hv[1], hv[2], hv[3]);
      }
    }
  }
}

DI void phase_gemm_dn(const Params& p, const GroupCtx& G, u16* YE, char* smem) {
  const u8* H = (const u8*)(p.ws + OFF_R1);
  const u8* WDN = (const u8*)(p.ws + OFF_WDN);
  const float* GATE = (const float*)(p.ws + OFF_GATE);
  const int lane = TIDX() & 63, wid = TIDX() >> 6, wr = wid >> 2, wc = wid & 3, fr = lane & 15, fq = lane >> 4;
  const int MT = G.cap >> 8;
  const int nitems = 16 * MT * 4;
  for (int item = VBID(); item < nitems; item += GDIM()) {
    const int e = item / (MT * 4); int mt, nt; tile_decode(item - e * (MT * 4), 4, mt, nt);
    f32x4 acc[8][4];
    gemm_tile_fp8<false>(H + ((size_t)e * G.cap + mt * 256) * 1408, 1408, nullptr, 0, WDN + (size_t)e * 1024 * 1408, 1408, nt * 256, 1408, acc, smem);
#pragma unroll
    for (int m = 0; m < 8; ++m) {
      const size_t row = (size_t)e * G.cap + mt * 256 + wr * 128 + m * 16 + fr;
      const float gate = GATE[row] * (64.0f / 128.0f);
#pragma unroll
      for (int n = 0; n < 4; ++n) {
        const int col = nt * 256 + wc * 64 + n * 16 + 4 * fq;
        *(u32*)((u8*)YE + row * 1024 + col) = pk4_fp8(acc[m][n][0] * gate, acc[m][n][1] * gate, acc[m][n][2] * gate, acc[m][n][3] * gate);
      }
    }
  }
}

struct NaCtx { int r, h, rs; size_t tokbase; };
DI NaCtx na_decode(int item) {
  NaCtx c; c.r = item & 31; c.h = (item >> 5) & 7; c.tokbase = (size_t)(item >> 8) * 2048;
  c.rs = min(max(c.r - 4, 0), 24);
  return c;
}
DI void na_loadV(const u16* P, const NaCtx& c, int tid, u32x4 (&R)[16]) {
#pragma unroll
  for (int k = 0; k < 16; ++k) {
    const int i = tid + 256 * k;
    const int key = i >> 3, pc = i & 7;
    R[k] = *(const u32x4*)(P + (c.tokbase + c.rs * 64 + key) * 3584 + 1024 + c.h * 64 + pc * 8);
  }
}

DI void na_phase(const Params& p, int n_pairs, char* smem0) {
  const int tid = TIDX() & 255, lane = tid & 63, wid = tid >> 6, fr = lane & 15, fq = lane >> 4;
  const int sub = TIDX() >> 8;
  char* smem = smem0 + sub * 75776;
  u16* sV = (u16*)smem;
  float* sR = (float*)(smem + 512 * 72 * 2);
  const u16* P = (const u16*)(p.ws + OFF_R1);
  u16* YM = (u16*)(p.ws + OFF_R3);
  const int gd = GDIM();
  const int cb = wid;
  const int bs = (cb == 0) ? 0 : (cb == 1) ? 8 : (cb == 2) ? 24 : 32;
  const int qc = cb * 16 + fr;
  const int wc0 = min(max(qc - 8, 0), 48);
  const unsigned vbase = (unsigned)(size_t)sV;
  const int q4 = (lane & 15) >> 2, p4 = lane & 3;
  int pair = VBID();
  u32x4 R[16];
  if (pair < n_pairs) { const NaCtx c0 = na_decode(2 * pair + sub); na_loadV(P, c0, tid, R); }
  while (pair < n_pairs) {
    const NaCtx c = na_decode(2 * pair + sub);
    const int r = c.r, h = c.h, rs = c.rs;
    const size_t qtok = c.tokbase + r * 64 + qc;
    bf16x8 qf[2];
    qf[0] = ld8(P + qtok * 3584 + h * 64 + fq * 8);
    qf[1] = ld8(P + qtok * 3584 + h * 64 + 32 + fq * 8);
    bf16x8 kfa[8][2];
#pragma unroll
    for (int f = 0; f < 8; ++f) {
      const int w = f >> 1, c0 = bs + (f & 1) * 16;
      const u16* kp = P + (c.tokbase + (rs + w) * 64 + c0 + fr) * 3584 + 512 + h * 64 + fq * 8;
      kfa[f][0] = ld8(kp); kfa[f][1] = ld8(kp + 32);
    }
    __syncthreads();
#pragma unroll
    for (int k = 0; k < 16; ++k) {
      const int i = tid + 256 * k;
      *(u32x4*)(sV + (i >> 3) * 72 + (i & 7) * 8) = R[k];
    }
    for (int i = tid; i < 465; i += 256) sR[i] = p.na_rpb[h * 465 + i];
    __syncthreads();
    const int next = pair + gd;
    bf16x8 kfb[8][2];
#pragma unroll
    for (int f = 0; f < 8; ++f) {
      const int w = 4 + (f >> 1), c0 = bs + (f & 1) * 16;
      const u16* kp = P + (c.tokbase + (rs + w) * 64 + c0 + fr) * 3584 + 512 + h * 64 + fq * 8;
      kfb[f][0] = ld8(kp); kfb[f][1] = ld8(kp + 32);
    }
    f32x4 s[16];
#pragma unroll
    for (int f = 0; f < 8; ++f) {
      f32x4 a = {0.f, 0.f, 0.f, 0.f};
      a = MFMA(kfa[f][0], qf[0], a);
      a = MFMA(kfa[f][1], qf[1], a);
      s[f] = a;
    }
#pragma unroll
    for (int f = 0; f < 8; ++f) {
      f32x4 a = {0.f, 0.f, 0.f, 0.f};
      a = MFMA(kfb[f][0], qf[0], a);
      a = MFMA(kfb[f][1], qf[1], a);
      s[8 + f] = a;
    }
    __builtin_amdgcn_sched_barrier(0);
    if (next < n_pairs) { const NaCtx cn = na_decode(2 * next + sub); na_loadV(P, cn, tid, R); }
    float mx = -INFINITY;
#pragma unroll
    for (int f = 0; f < 16; ++f) {
      const int w = f >> 1;
      const int dr = rs + w - r + 7;
#pragma unroll
      for (int j = 0; j < 4; ++j) {
        const int kc = bs + (f & 1) * 16 + 4 * fq + j;
        const bool valid = (kc >= wc0) && (kc < wc0 + 16);
        const int dc = min(max(kc - qc + 15, 0), 30);
        const float v = valid ? (s[f][j] * 0.125f + sR[dr * 31 + dc]) : -INFINITY;
        s[f][j] = v;
        mx = fmaxf(mx, v);
      }
    }
    mx = fmaxf(mx, __shfl_xor(mx, 16));
    mx = fmaxf(mx, __shfl_xor(mx, 32));
    float l = 0.f;
#pragma unroll
    for (int f = 0; f < 16; ++f)
#pragma unroll
      for (int j = 0; j < 4; ++j) {
        const float pv = __expf(s[f][j] - mx);
        s[f][j] = pv;
        l += pv;
      }
    l += __shfl_xor(l, 16);
    l += __shfl_xor(l, 32);
    f32x4 o[4];
#pragma unroll
    for (int cc = 0; cc < 4; ++cc) o[cc] = f32x4{0.f, 0.f, 0.f, 0.f};
#pragma unroll
    for (int w = 0; w < 8; w += 2) {
      const bf16x8 pb0 = pack8(s[2 * w], s[2 * w + 1]), pb1 = pack8(s[2 * w + 2], s[2 * w + 3]);
      const int key0 = w * 64 + bs + 4 * fq + q4;
      bf16x8 va[8];
      tr_read_8x2(vbase + (unsigned)((key0 * 72 + 4 * p4) * 2), vbase + (unsigned)(((key0 + 64) * 72 + 4 * p4) * 2), va);
#pragma unroll
      for (int cc = 0; cc < 4; ++cc) o[cc] = MFMA(va[cc], pb0, o[cc]);
#pragma unroll
      for (int cc = 0; cc < 4; ++cc) o[cc] = MFMA(va[4 + cc], pb1, o[cc]);
    }
    const float inv = 1.0f / l;
#pragma unroll
    for (int cc = 0; cc < 4; ++cc) {
      u32x2 ov; ov[0] = pk(o[cc][0] * inv, o[cc][1] * inv); ov[1] = pk(o[cc][2] * inv, o[cc][3] * inv);
      *(u32x2*)(YM + qtok * 1024 + h * 64 + 16 * cc + 4 * fq) = ov;
    }
    pair = next;
  }
}

DI float logsigmoidf(float x) { return fminf(x, 0.f) - log1pf(__expf(-fabsf(x))); }

DI void ml_item(const Params& p, const GroupCtx& G, int item, char* smem) {
  const int tid = TIDX(), lane = tid & 63, wid = tid >> 6, fr = lane & 15, fq = lane >> 4;
  const int eh = item & 1, dir = (item >> 1) & 1, h = (item >> 2) & 3, b = item >> 4;
  u16* sK = (u16*)smem;
  u16* sV = sK + 128 * 136;
  u16* sC = sV + 128 * 72;
  float* s_a = (float*)(sC + 80 * 136);
  float* s_M = s_a + 128;
  float* s_wi = s_a + 256;
  float* s_ws = s_a + 384;
  float* s_en = s_a + 512;
  float* s_sc = s_a + 640;
  const u16* P = (const u16*)(p.ws + OFF_R1);
  const float* GT = (const float*)(p.ws + OFF_GATES);
  u16* HOUT = (u16*)(p.ws + OFF_R4) + (size_t)dir * G.T * 512;
  const size_t tokbase = (size_t)b * 2048;
  const float kscale = 0.08838834764831845f;
  const unsigned kbase = (unsigned)(size_t)sK, vbase = (unsigned)(size_t)sV;
  const int q4 = (lane & 15) >> 2, p4 = lane & 3;
  const bf16x8 ones = {16256, 16256, 16256, 16256, 16256, 16256, 16256, 16256};
  f32x4 Cacc[5];
#pragma unroll
  for (int n = 0; n < 5; ++n) Cacc[n] = f32x4{0.f, 0.f, 0.f, 0.f};
  float mcarry = 0.f;
  u32x4 RK[4], RV[2];
  float gn[4] = {0.f, 0.f, 0.f, 0.f};
#define CTOK(cb_, tau) ((cb_) + (size_t)(dir ? 127 - (tau) : (tau)))
  auto prefetch = [&](size_t cb_) {
#pragma unroll
    for (int k = 0; k < 4; ++k) { const int i = tid + NTHR * k; RK[k] = *(const u32x4*)(P + CTOK(cb_, i >> 4) * 3584 + 2048 + h * 128 + (i & 15) * 8); }
#pragma unroll
    for (int k = 0; k < 2; ++k) { const int i = tid + NTHR * k; RV[k] = *(const u32x4*)(P + CTOK(cb_, i >> 3) * 3584 + 2560 + h * 128 + eh * 64 + (i & 7) * 8); }
    if (wid == 0) {
      gn[0] = GT[CTOK(cb_, 2 * lane) * 16 + dir * 4 + h];     gn[1] = GT[CTOK(cb_, 2 * lane + 1) * 16 + dir * 4 + h];
      gn[2] = GT[CTOK(cb_, 2 * lane) * 16 + 8 + dir * 4 + h]; gn[3] = GT[CTOK(cb_, 2 * lane + 1) * 16 + 8 + dir * 4 + h];
    }
  };
  prefetch(tokbase + (size_t)(dir ? 15 : 0) * 128);
  for (int cc = 0; cc < 16; ++cc) {
    const int chunk = dir ? 15 - cc : cc;
    const size_t cbase = tokbase + (size_t)chunk * 128;
#define TOK(tau) (cbase + (size_t)(dir ? 127 - (tau) : (tau)))
    __syncthreads();
#pragma unroll
    for (int k = 0; k < 4; ++k) { const int i = tid + NTHR * k; *(u32x4*)(sK + (i >> 4) * 136 + (i & 15) * 8) = RK[k]; }
#pragma unroll
    for (int k = 0; k < 2; ++k) { const int i = tid + NTHR * k; *(u32x4*)(sV + (i >> 3) * 72 + (i & 7) * 8) = RV[k]; }
    bf16x8 qf[4];
    {
      const u16* qp = P + TOK(16 * wid + fr) * 3584 + 1536 + h * 128 + fq * 8;
#pragma unroll
      for (int ks = 0; ks < 4; ++ks) qf[ks] = ld8(qp + ks * 32);
    }
#pragma unroll
    for (int n = 0; n < 5; ++n) {
      u32x2 o; o[0] = pk(Cacc[n][0], Cacc[n][1]); o[1] = pk(Cacc[n][2], Cacc[n][3]);
      *(u32x2*)(sC + (16 * n + fr) * 136 + 16 * wid + 4 * fq) = o;
    }
    if (wid == 0) {
      const int t0 = 2 * lane, t1 = 2 * lane + 1;
      const float ig0 = gn[0], ig1 = gn[1];
      const float lf0 = logsigmoidf(gn[2]);
      const float lf1 = logsigmoidf(gn[3]);
      const float ps = lf0 + lf1;
      float sc = ps;
#pragma unroll
      for (int o = 1; o < 64; o <<= 1) { const float t = __shfl_up(sc, o); if (lane >= o) sc += t; }
      const float excl = sc - ps;
      const float b0 = excl + lf0, b1 = sc;
      const float a0 = ig0 - b0, a1 = ig1 - b1;
      float sm = fmaxf(a0, a1);
#pragma unroll
      for (int o = 1; o < 64; o <<= 1) { const float t = __shfl_up(sm, o); if (lane >= o) sm = fmaxf(sm, t); }
      float exm = __shfl_up(sm, 1);
      if (lane == 0) exm = -INFINITY;
      const float pm0 = fmaxf(exm, a0), pm1 = sm;
      const float M0 = fmaxf(mcarry, pm0), M1 = fmaxf(mcarry, pm1);
      const float blast = __shfl(sc, 63), M127 = __shfl(M1, 63);
      s_a[t0] = a0; s_a[t1] = a1;
      s_M[t0] = M0; s_M[t1] = M1;
      s_wi[t0] = __expf(mcarry - M0); s_wi[t1] = __expf(mcarry - M1);
      s_en[t0] = __expf(-(b0 + M0)); s_en[t1] = __expf(-(b1 + M1));
      s_ws[t0] = __expf(a0 - M127) * kscale; s_ws[t1] = __expf(a1 - M127) * kscale;
      if (lane == 0) { s_sc[0] = __expf(mcarry - M127); s_sc[1] = blast + M127; }
    }
    __syncthreads();
    const float decay = s_sc[0];
    mcarry = s_sc[1];
    if (cc + 1 < 16) prefetch(tokbase + (size_t)(dir ? 14 - cc : cc + 1) * 128);
    {
      const int tb = wid;
      const int tl = 16 * tb + fr;
      f32x4 acc[5];
      const f32x4 wi = *(const f32x4*)(s_wi + 16 * tb + 4 * fq);
#pragma unroll
      for (int n = 0; n < 5; ++n) {
        f32x4 a = {0.f, 0.f, 0.f, 0.f};
#pragma unroll
        for (int ks = 0; ks < 4; ++ks) a = MFMA(qf[ks], ld8(sC + (16 * n + fr) * 136 + 32 * ks + 8 * fq), a);
#pragma unroll
        for (int j = 0; j < 4; ++j) a[j] *= wi[j];
        acc[n] = a;
      }
      const float Mt = s_M[tl];
      const int npair = (tb >> 1) + 1;
#pragma unroll 1
      for (int i = 0; i < npair; ++i) {
        f32x4 sf[2];
#pragma unroll
        for (int u = 0; u < 2; ++u) {
          const int sb = 2 * i + u;
          f32x4 a = {0.f, 0.f, 0.f, 0.f};
          if (sb <= tb) {
#pragma unroll
            for (int ks = 0; ks < 4; ++ks) a = MFMA(ld8(sK + (16 * sb + fr) * 136 + 32 * ks + 8 * fq), qf[ks], a);
          }
          const f32x4 av = *(const f32x4*)(s_a + 16 * sb + 4 * fq);
#pragma unroll
          for (int j = 0; j < 4; ++j) {
            const int si = 16 * sb + 4 * fq + j;
            a[j] = (si <= tl) ? a[j] * kscale * __expf(av[j] - Mt) : 0.f;
          }
          sf[u] = a;
        }
        const bf16x8 pa = pack8(sf[0], sf[1]);
        const int row0 = 32 * i + 4 * fq + q4;
#pragma unroll
        for (int n = 0; n < 4; ++n) {
          const unsigned a0 = vbase + (unsigned)((row0 * 72 + 16 * n + 4 * p4) * 2);
          acc[n] = MFMA(pa, tr_read2(a0, a0 + 16 * 72 * 2), acc[n]);
        }
        acc[4] = MFMA(pa, ones, acc[4]);
      }
      const f32x4 en = *(const f32x4*)(s_en + 16 * tb + 4 * fq);
#pragma unroll
      for (int j = 0; j < 4; ++j) {
        const int t = 16 * tb + 4 * fq + j;
        const float inv = 1.0f / fmaxf(fabsf(acc[4][j]), en[j]);
        u16* hp = HOUT + TOK(t) * 512 + h * 128 + eh * 64 + fr;
#pragma unroll
        for (int n = 0; n < 4; ++n) hp[16 * n] = (u16)(pk(acc[n][j] * inv, 0.f) & 0xffffu);
      }
    }
    __syncthreads();
    for (int i = tid; i < 128 * 16; i += NTHR) {
      const int tau = i >> 4, pc = i & 15;
      const float w = s_ws[tau];
      u32x4 v = *(u32x4*)(sK + tau * 136 + pc * 8);
#pragma unroll
      for (int k = 0; k < 4; ++k) v[k] = pk(bflo(v[k]) * w, bfhi(v[k]) * w);
      *(u32x4*)(sK + tau * 136 + pc * 8) = v;
    }
    __syncthreads();
#pragma unroll
    for (int n = 0; n < 5; ++n)
#pragma unroll
      for (int j = 0; j < 4; ++j) Cacc[n][j] *= decay;
#pragma unroll
    for (int ks = 0; ks < 4; ++ks) {
      const int row0 = 32 * ks + 4 * fq + q4;
      const unsigned ak = kbase + (unsigned)((row0 * 136 + 16 * wid + 4 * p4) * 2);
      const bf16x8 ka = tr_read2(ak, ak + 16 * 136 * 2);
#pragma unroll
      for (int n = 0; n < 5; ++n) {
        bf16x8 bv = ones;
        if (n < 4) {
          const unsigned a0 = vbase + (unsigned)((row0 * 72 + 16 * n + 4 * p4) * 2);
          bv = tr_read2(a0, a0 + 16 * 72 * 2);
        }
        Cacc[n] = MFMA(ka, bv, Cacc[n]);
      }
    }
#undef TOK
  }
#undef CTOK
}

DI void phase_mix0(const Params& p, const GroupCtx& G, char* smem) {
  const int n_ml = G.NB * 16;
  for (int item = VBID(); item < n_ml; item += GDIM()) ml_item(p, G, item, smem);
  na_phase(p, G.NB * 128, smem);
}

DI void phase_comb0(const Params& p, const GroupCtx& G) {
  const int lane = TIDX() & 63, wid = TIDX() >> 6;
  const u16* HF = (const u16*)(p.ws + OFF_R4);
  const u16* HB = HF + (size_t)G.T * 512;
  const u16* P = (const u16*)(p.ws + OFF_R1);
  u16* YM = (u16*)(p.ws + OFF_R3);
  const int col = (lane >> 4) * 128 + (lane & 15) * 8;
  for (int t = BIDX() * NWAV + wid; t < G.T; t += GDIM() * NWAV) {
    const u32x4 a = *(const u32x4*)(HF + (size_t)t * 512 + col), b = *(const u32x4*)(HB + (size_t)t * 512 + col);
    float x[8];
#pragma unroll
    for (int k = 0; k < 4; ++k) { x[2 * k] = bflo(a[k]) + bflo(b[k]); x[2 * k + 1] = bfhi(a[k]) + bfhi(b[k]); }
    float s = 0.f;
#pragma unroll
    for (int k = 0; k < 8; ++k) s += x[k];
#pragma unroll
    for (int o = 8; o >= 1; o >>= 1) s += __shfl_xor(s, o);
    const float mean = s * (1.0f / 128.0f);
    float v = 0.f;
#pragma unroll
    for (int k = 0; k < 8; ++k) { const float d = x[k] - mean; v += d * d; }
#pragma unroll
    for (int o = 8; o >= 1; o >>= 1) v += __shfl_xor(v, o);
    const float rstd = rsqrtf(v * (1.0f / 128.0f) + LN_EPS_F);
    const u32x4 ob = *(const u32x4*)(P + (size_t)t * 3584 + 3072 + col);
    float y[8];
#pragma unroll
    for (int k = 0; k < 8; ++k) {
      const float o = (k & 1) ? bfhi(ob[k >> 1]) : bflo(ob[k >> 1]);
      const float sg = 1.0f / (1.0f + __expf(-o));
      y[k] = sg * (x[k] - mean) * rstd * p.ml_norm_g[col + k];
    }
    u32x4 ov; ov[0] = pk(y[0], y[1]); ov[1] = pk(y[2], y[3]); ov[2] = pk(y[4], y[5]); ov[3] = pk(y[6], y[7]);
    *(u32x4*)(YM + (size_t)t * 1024 + 512 + col) = ov;
  }
}

constexpr size_t OFF_LSE = OFF_R1 + 402653184;

DI u16* da_partial(const Params& p, const GroupCtx& G, int br) {
  return br == 0 ? (u16*)(p.ws + OFF_R4) : (br == 1 ? G.p1 : (u16*)(p.ws + OFF_R3));
}

struct DaCtx { int br, g, sh, n, i0, h; size_t tokbase; };
DI DaCtx da_decode(int item) {
  DaCtx c;
  const int sub = item % 48, bh = item / 48;
  c.h = bh & 15;
  c.tokbase = (size_t)(bh >> 4) * 2048;
  int blk;
  if (sub < 16) { c.br = 0; c.g = 0; blk = sub; }
  else if (sub < 32) { c.br = 1; c.g = (sub - 16) >> 2; blk = (sub - 16) & 3; }
  else { c.br = 2; c.g = sub - 32; blk = 0; }
  c.sh = 2 * c.br; c.n = 2048 >> c.sh; c.i0 = blk * 128;
  return c;
}
DI void da_load(const u16* P, const DaCtx& c, int tid, int lane, int wid, u32x4 (&R)[9], bf16x8 (&Q)[2]) {
#pragma unroll
  for (int k = 0; k < 9; ++k) {
    const int i = tid + NTHR * k;
    const int kl = min(i >> 4, 271), pc = i & 15;
    const int u = min(max(c.i0 - 64 + kl, 0), c.n - 1);
    R[k] = *(const u32x4*)(P + (c.tokbase + ((size_t)u << c.sh) + c.g) * 3072 + 1024 + c.h * 64 + (pc >> 3) * 1024 + (pc & 7) * 8);
  }
  const int uq = c.i0 + 16 * wid + (lane & 15);
  const u16* qp = P + (c.tokbase + ((size_t)uq << c.sh) + c.g) * 3072 + c.h * 64 + (lane >> 4) * 8;
  Q[0] = ld8(qp); Q[1] = ld8(qp + 32);
}
DI void da_store(char* smem, int tid, const u32x4 (&R)[9]) {
  u16* sK = (u16*)smem;
  u16* sV = sK + 272 * 72;
#pragma unroll
  for (int k = 0; k < 9; ++k) {
    const int i = tid + NTHR * k;
    if (i < 272 * 16) {
      const int kl = i >> 4, pc = i & 15;
      *(u32x4*)((pc >> 3 ? sV : sK) + kl * 72 + (pc & 7) * 8) = R[k];
    }
  }
}
DI void da_compute(const Params& p, const GroupCtx& G, const DaCtx& c, const bf16x8 (&qf)[2], char* smem) {
  const int tid = TIDX(), lane = tid & 63, wid = tid >> 6, fr = lane & 15, fq = lane >> 4;
  const int br = c.br, g = c.g, sh = c.sh, n = c.n, i0 = c.i0, h = c.h;
  u16* sK = (u16*)smem;
  u16* sV = sK + 272 * 72;
  u16* PO = da_partial(p, G, br);
  float* LSE = (float*)(p.ws + OFF_LSE) + (size_t)br * G.T * 16;
  const int uq = i0 + 16 * wid + fr;
  const size_t qtok = c.tokbase + ((size_t)uq << sh) + g;
  f32x4 s[10];
  float mx = -INFINITY;
  const bool edge = (i0 - 64 + 16 * wid < 0) || (i0 - 64 + 16 * wid + 144 > n);
#pragma unroll
  for (int f = 0; f < 9; ++f) {
    const u16* kp = sK + (16 * wid + 16 * f + fr) * 72 + fq * 8;
    f32x4 a = {0.f, 0.f, 0.f, 0.f};
    a = MFMA(ld8(kp), qf[0], a);
    a = MFMA(ld8(kp + 32), qf[1], a);
    if (f == 0 || f == 8) {
#pragma unroll
      for (int j = 0; j < 4; ++j) {
        const int d = 16 * f - 64 + 4 * fq + j - fr;
        const bool valid = (f == 0) ? (d >= -64) : (d <= 64);
        a[j] = valid ? a[j] : -INFINITY;
      }
    }
    if (edge) {
#pragma unroll
      for (int j = 0; j < 4; ++j) {
        const int u = i0 - 64 + 16 * wid + 16 * f + 4 * fq + j;
        a[j] = ((u >= 0) && (u < n)) ? a[j] : -INFINITY;
      }
    }
#pragma unroll
    for (int j = 0; j < 4; ++j) mx = fmaxf(mx, a[j]);
    s[f] = a;
  }
  mx = fmaxf(mx, __shfl_xor(mx, 16));
  mx = fmaxf(mx, __shfl_xor(mx, 32));
  float l = 0.f;
#pragma unroll
  for (int f = 0; f < 9; ++f)
#pragma unroll
    for (int j = 0; j < 4; ++j) {
      const float pv = __expf(s[f][j] - mx);
      s[f][j] = pv;
      l += pv;
    }
  s[9] = f32x4{0.f, 0.f, 0.f, 0.f};
  l += __shfl_xor(l, 16);
  l += __shfl_xor(l, 32);
  f32x4 o[4];
#pragma unroll
  for (int cc = 0; cc < 4; ++cc) o[cc] = f32x4{0.f, 0.f, 0.f, 0.f};
  const unsigned vbase = (unsigned)(size_t)sV;
  const int q4 = (lane & 15) >> 2, p4 = lane & 3;
  const unsigned vrow = vbase + (unsigned)((((16 * wid + 4 * fq + q4) * 72) + 4 * p4) * 2);
#pragma unroll
  for (int kk = 0; kk < 4; kk += 2) {
    const bf16x8 pb0 = pack8(s[2 * kk], s[2 * kk + 1]), pb1 = pack8(s[2 * kk + 2], s[2 * kk + 3]);
    bf16x8 va[8];
    tr_read_8x2(vrow + (unsigned)(kk * 32 * 144), vrow + (unsigned)((kk + 1) * 32 * 144), va);
#pragma unroll
    for (int cc = 0; cc < 4; ++cc) o[cc] = MFMA(va[cc], pb0, o[cc]);
#pragma unroll
    for (int cc = 0; cc < 4; ++cc) o[cc] = MFMA(va[4 + cc], pb1, o[cc]);
  }
  {
    const bf16x8 pb = pack8(s[8], s[9]);
    bf16x8 va[4];
    tr_read_4x2(vrow + (unsigned)(4 * 32 * 144), va);
#pragma unroll
    for (int cc = 0; cc < 4; ++cc) o[cc] = MFMA(va[cc], pb, o[cc]);
  }
  const float inv = 1.0f / l;
#pragma unroll
  for (int cc = 0; cc < 4; ++cc) {
    u32x2 ov; ov[0] = pk(o[cc][0] * inv, o[cc][1] * inv); ov[1] = pk(o[cc][2] * inv, o[cc][3] * inv);
    *(u32x2*)(PO + qtok * 1024 + h * 64 + 16 * cc + 4 * fq) = ov;
  }
  if (fq == 0) LSE[qtok * 16 + h] = mx + __logf(l);
}

DI void phase_mix1(const Params& p, const GroupCtx& G, char* smem) {
  const int tid = TIDX(), lane = tid & 63, wid = tid >> 6;
  const u16* P = (const u16*)(p.ws + OFF_R1);
  const int nitems = G.NB * 16 * 48;
  const int gd = GDIM();
  int item = VBID();
  u32x4 R[9];
  bf16x8 qn[2];
  DaCtx cn = da_decode(item < nitems ? item : 0);
  if (item < nitems) da_load(P, cn, tid, lane, wid, R, qn);
  while (item < nitems) {
    const DaCtx cc = cn;
    bf16x8 qc[2];
    qc[0] = qn[0]; qc[1] = qn[1];
    __syncthreads();
    da_store(smem, tid, R);
    __syncthreads();
    const int next = item + gd;
    if (next < nitems) { cn = da_decode(next); da_load(P, cn, tid, lane, wid, R, qn); }
    da_compute(p, G, cc, qc, smem);
    item = next;
  }
}

DI void phase_comb1(const Params& p, const GroupCtx& G) {
  const int lane = TIDX() & 63, wid = TIDX() >> 6;
  const u16* P0 = da_partial(p, G, 0);
  const u16* P1 = da_partial(p, G, 1);
  u16* P2 = da_partial(p, G, 2);
  const float* LSE = (const float*)(p.ws + OFF_LSE);
  const int hd = lane >> 2;
  for (int t = BIDX() * NWAV + wid; t < G.T; t += GDIM() * NWAV) {
    const float l0 = LSE[(size_t)t * 16 + hd], l1 = LSE[((size_t)G.T + t) * 16 + hd], l2 = LSE[((size_t)2 * G.T + t) * 16 + hd];
    const float mm = fmaxf(l0, fmaxf(l1, l2));
    const float e0 = __expf(l0 - mm), e1 = __expf(l1 - mm), e2 = __expf(l2 - mm);
    const float is = 1.0f / (e0 + e1 + e2);
    const float w0 = e0 * is, w1 = e1 * is, w2 = e2 * is;
#pragma unroll
    for (int hh = 0; hh < 2; ++hh) {
      const size_t off = (size_t)t * 1024 + lane * 16 + hh * 8;
      const u32x4 a = *(const u32x4*)(P0 + off), bb = *(const u32x4*)(P1 + off), c = *(const u32x4*)(P2 + off);
      u32x4 ov;
#pragma unroll
      for (int k = 0; k < 4; ++k)
        ov[k] = pk(w0 * bflo(a[k]) + w1 * bflo(bb[k]) + w2 * bflo(c[k]), w0 * bfhi(a[k]) + w1 * bfhi(bb[k]) + w2 * bfhi(c[k]));
      *(u32x4*)(P2 + off) = ov;
    }
  }
}

DI void phase_ln1(const Params& p, const GroupCtx& G, int layer, char* smem) {
  const int tid = TIDX(), lane = tid & 63, wid = tid >> 6;
  float* wT = (float*)smem;
  const float* wr = p.ec_router + (size_t)layer * 16384;
  __syncthreads();
  for (int i = tid; i < 16384; i += NTHR) wT[(i & 15) * 1024 + (i >> 4)] = wr[i];
  __syncthreads();
  const u16* MIX = (const u16*)(p.ws + OFF_R1);
  const u16* XB = G.xb1;
  u16* X1 = (u16*)(p.ws + OFF_R4);
  float* AFF = (float*)(p.ws + OFF_AFF);
  const float* gam = p.ln_mix_g + layer * 1024;
  const float* bet = p.ln_mix_b + layer * 1024;
  u32x4 nmx[2];
  f32x4 nxf[4];
  u32x4 nxb[2];
  auto ld_tok = [&](int t) {
#pragma unroll
    for (int hh = 0; hh < 2; ++hh) {
      const int c = hh * 512 + lane * 8;
      nmx[hh] = *(const u32x4*)(MIX + (size_t)t * 1024 + c);
      if (layer == 0) {
        nxf[2 * hh] = *(const f32x4*)(G.xin + (size_t)t * 1024 + c);
        nxf[2 * hh + 1] = *(const f32x4*)(G.xin + (size_t)t * 1024 + c + 4);
      } else {
        nxb[hh] = *(const u32x4*)(XB + (size_t)t * 1024 + c);
      }
    }
  };
  const int tstride = GDIM() * NWAV;
  int t = BIDX() * NWAV + wid;
  if (t < G.T) ld_tok(t);
  for (; t < G.T; t += tstride) {
    float v[16];
#pragma unroll
    for (int hh = 0; hh < 2; ++hh) {
      float xi[8];
      if (layer == 0) {
#pragma unroll
        for (int k = 0; k < 4; ++k) { xi[k] = nxf[2 * hh][k]; xi[4 + k] = nxf[2 * hh + 1][k]; }
      } else {
#pragma unroll
        for (int k = 0; k < 4; ++k) { xi[2 * k] = bflo(nxb[hh][k]); xi[2 * k + 1] = bfhi(nxb[hh][k]); }
      }
#pragma unroll
      for (int k = 0; k < 4; ++k) {
        v[hh * 8 + 2 * k] = DN_ALPHA_F * xi[2 * k] + bflo(nmx[hh][k]);
        v[hh * 8 + 2 * k + 1] = DN_ALPHA_F * xi[2 * k + 1] + bfhi(nmx[hh][k]);
      }
    }
    if (t + tstride < G.T) ld_tok(t + tstride);
    float s = 0.f;
#pragma unroll
    for (int k = 0; k < 16; ++k) s += v[k];
    const float mean = wave_sum(s) * (1.0f / 1024.0f);
    float q = 0.f;
#pragma unroll
    for (int k = 0; k < 16; ++k) { const float d = v[k] - mean; q += d * d; }
    const float rstd = rsqrtf(wave_sum(q) * (1.0f / 1024.0f) + LN_EPS_F);
#pragma unroll
    for (int hh = 0; hh < 2; ++hh) {
      const int c = hh * 512 + lane * 8;
      const float4 g0 = *(const float4*)(gam + c), g1 = *(const float4*)(gam + c + 4);
      const float4 b0 = *(const float4*)(bet + c), b1 = *(const float4*)(bet + c + 4);
      const float gg[8] = {g0.x, g0.y, g0.z, g0.w, g1.x, g1.y, g1.z, g1.w};
      const float bb[8] = {b0.x, b0.y, b0.z, b0.w, b1.x, b1.y, b1.z, b1.w};
#pragma unroll
      for (int k = 0; k < 8; ++k) v[hh * 8 + k] = (v[hh * 8 + k] - mean) * rstd * gg[k] + bb[k];
      u32x4 ov; ov[0] = pk(v[hh * 8 + 0], v[hh * 8 + 1]); ov[1] = pk(v[hh * 8 + 2], v[hh * 8 + 3]);
      ov[2] = pk(v[hh * 8 + 4], v[hh * 8 + 5]); ov[3] = pk(v[hh * 8 + 6], v[hh * 8 + 7]);
      *(u32x4*)(X1 + (size_t)t * 1024 + c) = ov;
      u32x2 oq; oq[0] = pk4_fp8(v[hh * 8 + 0], v[hh * 8 + 1], v[hh * 8 + 2], v[hh * 8 + 3]); oq[1] = pk4_fp8(v[hh * 8 + 4], v[hh * 8 + 5], v[hh * 8 + 6], v[hh * 8 + 7]);
      *(u32x2*)((u8*)(p.ws + OFF_X1Q) + (size_t)t * 1024 + c) = oq;
    }
    float d16[16];
#pragma unroll
    for (int e = 0; e < 16; ++e) {
      float d = 0.f;
#pragma unroll
      for (int hh = 0; hh < 2; ++hh) {
        const float* wp = wT + e * 1024 + hh * 512 + lane * 8;
        const f32x4 w0 = *(const f32x4*)wp, w1 = *(const f32x4*)(wp + 4);
#pragma unroll
        for (int k = 0; k < 4; ++k) { d += v[hh * 8 + k] * w0[k]; d += v[hh * 8 + 4 + k] * w1[k]; }
      }
      d16[e] = d;
      if ((e & 3) == 3) __builtin_amdgcn_sched_barrier(0);
    }
    float d8[8];
    {
      const bool hi = (lane & 8) != 0;
#pragma unroll
      for (int k = 0; k < 8; ++k) {
        const float keep = hi ? d16[8 + k] : d16[k];
        const float send = hi ? d16[k] : d16[8 + k];
        d8[k] = keep + __shfl_xor(send, 8);
      }
    }
    float d4[4];
    {
      const bool hi = (lane & 4) != 0;
#pragma unroll
      for (int k = 0; k < 4; ++k) {
        const float keep = hi ? d8[4 + k] : d8[k];
        const float send = hi ? d8[k] : d8[4 + k];
        d4[k] = keep + __shfl_xor(send, 4);
      }
    }
    float d2[2];
    {
      const bool hi = (lane & 2) != 0;
#pragma unroll
      for (int k = 0; k < 2; ++k) {
        const float keep = hi ? d4[2 + k] : d4[k];
        const float send = hi ? d4[k] : d4[2 + k];
        d2[k] = keep + __shfl_xor(send, 2);
      }
    }
    float mylogit;
    {
      const bool hi = (lane & 1) != 0;
      const float keep = hi ? d2[1] : d2[0];
      const float send = hi ? d2[0] : d2[1];
      mylogit = keep + __shfl_xor(send, 1);
    }
    mylogit += __shfl_xor(mylogit, 16);
    mylogit += __shfl_xor(mylogit, 32);
    float mx = mylogit;
#pragma unroll
    for (int o = 8; o >= 1; o >>= 1) mx = fmaxf(mx, __shfl_xor(mx, o));
    const float ex = __expf(mylogit - mx);
    float se = ex;
#pragma unroll
    for (int o = 8; o >= 1; o >>= 1) se += __shfl_xor(se, o);
    if (lane < 16) AFF[(size_t)lane * G.T + t] = ex / se;
  }
}

DI void phase_sel(const Params& p, const GroupCtx& G, char* smem) {
  if (BIDX() >= 16) return;
  const int tid = TIDX(), lane = tid & 63, wid = tid >> 6;
  const int e = BIDX(), T = G.T, cap = G.cap;
  const u32* a = (const u32*)(p.ws + OFF_AFF) + (size_t)e * T;
  int* IDX = (int*)(p.ws + OFF_IDX) + e * cap;
  float* GATE = (float*)(p.ws + OFF_GATE) + e * cap;
  int* SEL = (int*)(p.ws + OFF_SEL);
  int* red = (int*)smem;
  int* scn = red + 16;
  const int per = T >> 9;
  const int tbeg = tid * per;
  u32 v[128];
#pragma unroll
  for (int i = 0; i < 32; ++i) {
    u32x4 x = {0u, 0u, 0u, 0u};
    if (i * 4 < per) x = *(const u32x4*)(a + tbeg + i * 4);
    v[4 * i] = x[0]; v[4 * i + 1] = x[1]; v[4 * i + 2] = x[2]; v[4 * i + 3] = x[3];
  }
  __syncthreads();
  u32 lo = 0u, hi = 0x3F800001u;
  int it = 0;
  while (hi - lo > 1u) {
    const u32 mid = lo + ((hi - lo) >> 1);
    int c = 0;
#pragma unroll
    for (int i = 0; i < 128; ++i) c += (v[i] >= mid) ? 1 : 0;
#pragma unroll
    for (int o = 32; o >= 1; o >>= 1) c += __shfl_xor(c, o);
    const int par = it & 1;
    if (lane == 0) red[par * 8 + wid] = c;
    __syncthreads();
    int tot = 0;
#pragma unroll
    for (int w = 0; w < NWAV; ++w) tot += red[par * 8 + w];
    if (tot >= cap) lo = mid; else hi = mid;
    ++it;
  }
  const u32 thr = lo;
  int my_gt = 0, my_eq = 0;
#pragma unroll
  for (int i = 0; i < 128; ++i) { my_gt += (v[i] > thr) ? 1 : 0; my_eq += (v[i] == thr) ? 1 : 0; }
  int sg = my_gt, se = my_eq;
#pragma unroll
  for (int o = 1; o < 64; o <<= 1) {
    const int tg = __shfl_up(sg, o), te = __shfl_up(se, o);
    if (lane >= o) { sg += tg; se += te; }
  }
  __syncthreads();
  if (lane == 63) { scn[wid * 2] = sg; scn[wid * 2 + 1] = se; }
  __syncthreads();
  int base_gt = sg - my_gt, base_eq = se - my_eq, cnt_gt = 0;
#pragma unroll
  for (int w = 0; w < NWAV; ++w) {
    const int g_ = scn[w * 2], e_ = scn[w * 2 + 1];
    if (w < wid) { base_gt += g_; base_eq += e_; }
    cnt_gt += g_;
  }
  const int need = cap - cnt_gt;
#pragma unroll 1
  for (int i0 = 0; i0 < per; i0 += 16) {
    u32 w[16];
#pragma unroll
    for (int k = 0; k < 4; ++k) {
      const u32x4 x = *(const u32x4*)(a + tbeg + i0 + 4 * k);
      w[4 * k] = x[0]; w[4 * k + 1] = x[1]; w[4 * k + 2] = x[2]; w[4 * k + 3] = x[3];
    }
    int sl[16];
#pragma unroll
    for (int k = 0; k < 16; ++k) {
      const u32 u = w[k];
      int slot = -1;
      if (u > thr) slot = base_gt++;
      else if (u == thr) { const int r = base_eq++; if (r < need) slot = cnt_gt + r; }
      sl[k] = slot;
    }
#pragma unroll
    for (int k = 0; k < 16; ++k) {
      const int t = tbeg + i0 + k;
      if (sl[k] >= 0) { IDX[sl[k]] = t; GATE[sl[k]] = __uint_as_float(w[k]); }
      SEL[(size_t)t * 16 + e] = sl[k];
    }
  }
}

DI void phase_ln2(const Params& p, const GroupCtx& G, int layer, const u16* YE) {
  const int lane = TIDX() & 63, wid = TIDX() >> 6;
  const u16* X1 = (const u16*)(p.ws + OFF_R4);
  const int* SEL = (const int*)(p.ws + OFF_SEL);
  u16* XB = G.xb1;
  const float* gam = p.ln_ffn_g + layer * 1024;
  const float* bet = p.ln_ffn_b + layer * 1024;
  u32x4 nx1[2];
  int nsel = -1;
  auto ld_tok = [&](int t) {
    nx1[0] = *(const u32x4*)(X1 + (size_t)t * 1024 + lane * 8);
    nx1[1] = *(const u32x4*)(X1 + (size_t)t * 1024 + 512 + lane * 8);
    nsel = SEL[(size_t)t * 16 + (lane & 15)];
  };
  const int tstride = GDIM() * NWAV;
  int t = BIDX() * NWAV + wid;
  if (t < G.T) ld_tok(t);
  for (; t < G.T; t += tstride) {
    float v[16];
#pragma unroll
    for (int hh = 0; hh < 2; ++hh)
#pragma unroll
      for (int k = 0; k < 4; ++k) { v[hh * 8 + 2 * k] = DN_ALPHA_F * bflo(nx1[hh][k]); v[hh * 8 + 2 * k + 1] = DN_ALPHA_F * bfhi(nx1[hh][k]); }
    const int selv = nsel;
    if (t + tstride < G.T) ld_tok(t + tstride);
    unsigned msk = (unsigned)(__ballot(selv >= 0) & 0xffffull);
    while (msk) {
      int ee[4];
      u32x2 y[4][2];
#pragma unroll
      for (int k = 0; k < 4; ++k) {
        ee[k] = msk ? (__ffs(msk) - 1) : -1;
        if (msk) msk &= msk - 1;
      }
#pragma unroll
      for (int k = 0; k < 4; ++k) {
        if (ee[k] >= 0) {
          const int s = __shfl(selv, ee[k]);
          const u8* yp = (const u8*)YE + ((size_t)ee[k] * G.cap + s) * 1024;
          y[k][0] = *(const u32x2*)(yp + lane * 8);
          y[k][1] = *(const u32x2*)(yp + 512 + lane * 8);
        } else {
          y[k][0] = u32x2{0u, 0u}; y[k][1] = u32x2{0u, 0u};
        }
      }
#pragma unroll
      for (int k = 0; k < 4; ++k)
#pragma unroll
        for (int hh = 0; hh < 2; ++hh)
#pragma unroll
          for (int j = 0; j < 2; ++j) {
            const f32x2_t lo = __builtin_amdgcn_cvt_pk_f32_fp8((int)y[k][hh][j], false), hi = __builtin_amdgcn_cvt_pk_f32_fp8((int)y[k][hh][j], true);
            v[hh * 8 + 4 * j] += lo[0] * (1.0f / 64.0f); v[hh * 8 + 4 * j + 1] += lo[1] * (1.0f / 64.0f);
            v[hh * 8 + 4 * j + 2] += hi[0] * (1.0f / 64.0f); v[hh * 8 + 4 * j + 3] += hi[1] * (1.0f / 64.0f);
          }
    }
    float s = 0.f;
#pragma unroll
    for (int k = 0; k < 16; ++k) s += v[k];
    const float mean = wave_sum(s) * (1.0f / 1024.0f);
    float q = 0.f;
#pragma unroll
    for (int k = 0; k < 16; ++k) { const float d = v[k] - mean; q += d * d; }
    const float rstd = rsqrtf(wave_sum(q) * (1.0f / 1024.0f) + LN_EPS_F);
#pragma unroll
    for (int hh = 0; hh < 2; ++hh) {
      const int c = hh * 512 + lane * 8;
      const float4 g0 = *(const float4*)(gam + c), g1 = *(const float4*)(gam + c + 4);
      const float4 b0 = *(const float4*)(bet + c), b1 = *(const float4*)(bet + c + 4);
      const float gg[8] = {g0.x, g0.y, g0.z, g0.w, g1.x, g1.y, g1.z, g1.w};
      const float bb[8] = {b0.x, b0.y, b0.z, b0.w, b1.x, b1.y, b1.z, b1.w};
      float y[8];
#pragma unroll
      for (int k = 0; k < 8; ++k) y[k] = (v[hh * 8 + k] - mean) * rstd * gg[k] + bb[k];
      if (layer == 0) {
        u32x4 ov; ov[0] = pk(y[0], y[1]); ov[1] = pk(y[2], y[3]); ov[2] = pk(y[4], y[5]); ov[3] = pk(y[6], y[7]);
        *(u32x4*)(XB + (size_t)t * 1024 + c) = ov;
      } else {
        float* op = G.out + (size_t)t * 1024 + c;
        *(float4*)op = make_float4(y[0], y[1], y[2], y[3]);
        *(float4*)(op + 4) = make_float4(y[4], y[5], y[6], y[7]);
      }
    }
  }
}


#define XB_TMO      128
#define XB_XCNT(j)  (256  + 64 * (j))
#define XB_XSUB(j)  (1280 + 64 * (j))
#define XB_XGEN(j)  (2304 + 64 * (j))
#define XB_TOP      3328
#define XB_TOPGEN   3392
#define XCD_BAR_WORDS 3456
#define XB_SPIN_CAP (1u << 22)
DI unsigned xb_ld(unsigned* p)              { return __hip_atomic_load(p, __ATOMIC_RELAXED, __HIP_MEMORY_SCOPE_AGENT); }
DI unsigned xb_add(unsigned* p, unsigned v) { return __hip_atomic_fetch_add(p, v, __ATOMIC_RELAXED, __HIP_MEMORY_SCOPE_AGENT); }
DI unsigned xb_xcc_id() { return (unsigned)__builtin_amdgcn_s_getreg((3 << 11) | 20) & 0xFu; }
#define XB_SPIN(cond, bar) do { unsigned _sp = 0; while (cond) { __builtin_amdgcn_s_sleep(1); \
    if ((++_sp & 255u) == 0u) { if (xb_ld(&(bar)[XB_TMO])) break; if (_sp > XB_SPIN_CAP) { atomicAdd(&(bar)[XB_TMO], 1u); break; } } } } while (0)
struct XcdBarrier { unsigned* bar; unsigned x; volatile LAS unsigned* st; };
DI XcdBarrier xcd_barrier_post(unsigned* bar, volatile LAS unsigned* st) {
  XcdBarrier b; b.bar = bar; b.x = xb_xcc_id(); b.st = st;
  if (threadIdx.x == 0) (void)xb_add(&bar[XB_XCNT(b.x)], 1u);
  return b;
}
DI void xcd_barrier_complete(unsigned* bar, unsigned x, unsigned& nloc, unsigned& nx) {
  const unsigned G = gridDim.x * gridDim.y * gridDim.z;
  unsigned sum, cnt, mine, sp = 0u;
  for (;;) {
    sum = 0u; cnt = 0u; mine = 0u;
#pragma unroll
    for (unsigned j = 0; j < 16; ++j) { const unsigned c = xb_ld(&bar[XB_XCNT(j)]); sum += c; cnt += (c > 0u) ? 1u : 0u; mine = (j == x) ? c : mine; }
    if (sum == G) break;
    __builtin_amdgcn_s_sleep(1);
    if ((++sp & 255u) == 0u) { if (xb_ld(&bar[XB_TMO])) break; if (sp > XB_SPIN_CAP) { atomicAdd(&bar[XB_TMO], 1u); break; } }
  }
  nloc = mine > 0u ? mine : 1u; nx = cnt > 0u ? cnt : 1u;
}
DI void xcd_barrier(const XcdBarrier& b) {
  asm volatile("s_waitcnt vmcnt(0)" ::: "memory");
  __syncthreads();
  if (threadIdx.x == 0) {
    unsigned* bar = b.bar;
    __builtin_amdgcn_s_waitcnt(0);
    unsigned nloc = b.st[0], nx = b.st[1];
    if (nloc == 0u) { xcd_barrier_complete(bar, b.x, nloc, nx); b.st[0] = nloc; b.st[1] = nx; }
    const unsigned old = xb_add(&bar[XB_XSUB(b.x)], 1u);
    const unsigned gen = old / nloc;
    if (old + 1u == (gen + 1u) * nloc) {
      __builtin_amdgcn_fence(__ATOMIC_RELEASE, "agent");
      asm volatile("s_waitcnt vmcnt(0)" ::: "memory");
      const unsigned og = xb_add(&bar[XB_TOP], 1u);
      const unsigned tg = og / nx;
      if (og + 1u == (tg + 1u) * nx) xb_add(&bar[XB_TOPGEN], 1u);
      else XB_SPIN(xb_ld(&bar[XB_TOPGEN]) == tg, bar);
      __builtin_amdgcn_fence(__ATOMIC_ACQUIRE, "agent");
      xb_add(&bar[XB_XGEN(b.x)], 1u);
      asm volatile("s_waitcnt vmcnt(0)" ::: "memory");
    } else {
      XB_SPIN(xb_ld(&bar[XB_XGEN(b.x)]) == gen, bar);
      __builtin_amdgcn_fence(__ATOMIC_ACQUIRE, "agent");
      asm volatile("s_waitcnt vmcnt(0)" ::: "memory");
    }
  }
  __syncthreads();
}

DI void run_phase(const Params& p, int ph, char* smem) {
  if (ph == 0) { phase_prologue(p, smem); return; }
  int seg, s;
  if (ph <= 20) { seg = (ph - 1) / 10; s = (ph - 1) % 10; }
  else { seg = 2 + (ph - 21) / 9; s = 10 + (ph - 21) % 9; }
  const int g = seg & 1;
  GroupCtx G;
  float* out_p = p.out;
  float* out_s = p.out + (size_t)32768 * 1024;
  if (g == 0) { G.T = 32768; G.NB = 16; G.cap = 4096; G.xin = p.x_prompt; G.out = out_p; }
  else { G.T = 65536; G.NB = 32; G.cap = 8192; G.xin = p.x_sample; G.out = out_s; }
  G.xb1 = (g == 0) ? (u16*)out_p : (u16*)(p.ws + OFF_R2);
  G.p1 = (g == 0) ? ((u16*)out_p + (size_t)32768 * 1024) : (u16*)out_s;
  u16* YE0 = (u16*)out_s;
  u16* YE1 = (g == 0) ? (u16*)(p.ws + OFF_R3) : (u16*)(p.ws + OFF_R2);
  switch (s) {
    case 0: phase_conv0(p, G, smem); break;
    case 1: phase_gemm_in0(p, G, smem); break;
    case 2: phase_mix0(p, G, smem); break;
    case 3: phase_comb0(p, G); break;
    case 4: phase_gemm_out(p, G, 0, smem); break;
    case 5: phase_ln1(p, G, 0, smem); break;
    case 6: phase_sel(p, G, smem); break;
    case 7: phase_gemm_gu(p, G, smem); break;
    case 8: phase_gemm_dn(p, G, YE0, smem); break;
    case 9:
      phase_ln2(p, G, 0, YE0);
      if (g == 1) { for (int item = BIDX(); item < 3 * 5632 / 2; item += GDIM()) conv_moe_layer(p, 1, item, smem); }
      break;
    case 10: phase_gemm_in1(p, G, smem); break;
    case 11: phase_mix1(p, G, smem); break;
    case 12: phase_comb1(p, G); break;
    case 13: phase_gemm_out(p, G, 1, smem); break;
    case 14: phase_ln1(p, G, 1, smem); break;
    case 15: phase_sel(p, G, smem); break;
    case 16: phase_gemm_gu(p, G, smem); break;
    case 17: phase_gemm_dn(p, G, YE1, smem); break;
    case 18: phase_ln2(p, G, 1, YE1); break;
    default: break;
  }
}

#ifndef REPEAT_MASK
#define REPEAT_MASK 0
#endif
#ifndef DBG_STOP
#define DBG_STOP 0
#endif
#ifndef DBG_OFF
#define DBG_OFF OFF_R4
#endif
__global__ void __launch_bounds__(256, 2) dbg_dump(Params p) {
  const u16* src = (const u16*)(p.ws + DBG_OFF);
  const size_t n = (size_t)98304 * 1024, nsrc = (size_t)32768 * 1024;
  for (size_t i = (size_t)blockIdx.x * 256 + threadIdx.x; i < n; i += (size_t)gridDim.x * 256)
  {
    float v = (i < nsrc) ? __uint_as_float(((u32)src[i]) << 16) : 0.f;
    if (v != v) v = 1.0e6f; else if (fabsf(v) > 1.0e30f) v = 3.0e6f;
    p.out[i] = v;
  }
}
__global__ void __launch_bounds__(512) hybrid_mega(Params p, int ph_lo, int ph_hi) {
  extern __shared__ __attribute__((aligned(16))) char smem[];
  volatile LAS unsigned* xst = (volatile LAS unsigned*)((LAS char*)smem + (SMEM_BYTES - 16));
  if (threadIdx.x == 0) { xst[0] = 0u; xst[1] = 0u; }
  __syncthreads();
  const XcdBarrier xb = xcd_barrier_post((unsigned*)(p.ws + OFF_BAR), xst);
#pragma unroll 1
  for (int ph = ph_lo; ph < ph_hi; ++ph) {
    Params q = p;
#define LAUNDER(f) asm volatile("" : "+s"(q.f))
    LAUNDER(x_prompt); LAUNDER(x_sample); LAUNDER(even_w_in); LAUNDER(ml_gate_bias); LAUNDER(na_rpb); LAUNDER(ml_norm_g);
    LAUNDER(even_w_out); LAUNDER(da_w_in); LAUNDER(da_w_out); LAUNDER(ln_mix_g); LAUNDER(ln_mix_b); LAUNDER(ec_router);
    LAUNDER(ec_w_gate); LAUNDER(ec_w_up); LAUNDER(ec_w_down); LAUNDER(ln_ffn_g); LAUNDER(ln_ffn_b); LAUNDER(out); LAUNDER(ws);
#undef LAUNDER
    int reps = 1;
#if REPEAT_MASK
    if (ph > 0 && ((REPEAT_MASK >> (ph % 32)) & 1)) reps = 2;
#endif
#pragma unroll 1
    for (int rr = 0; rr < reps; ++rr) {
      if (rr) xcd_barrier(xb);
      run_phase(q, ph, smem);
    }
    if (ph + 1 < ph_hi) { if (ph_lo < 0) cg::this_grid().sync(); else xcd_barrier(xb); }
  }
}

extern "C" void kernel_launch(void* const* d_in, const int* in_sizes, int n_in, void* d_out, int out_size,
                              void* d_ws, size_t ws_size, hipStream_t stream) {
  (void)in_sizes; (void)n_in; (void)out_size;
  Params p;
  memset(&p, 0, sizeof(p));
  p.x_prompt = (const float*)d_in[0];   p.x_sample = (const float*)d_in[1];
  p.even_w_in = (const float*)d_in[2];  p.ml_gate_bias = (const float*)d_in[3];
  p.na_rpb = (const float*)d_in[4];     p.ml_norm_g = (const float*)d_in[5];
  p.even_w_out = (const float*)d_in[6]; p.da_w_in = (const float*)d_in[7];
  p.da_w_out = (const float*)d_in[8];   p.ln_mix_g = (const float*)d_in[9];
  p.ln_mix_b = (const float*)d_in[10];  p.ec_router = (const float*)d_in[11];
  p.ec_w_gate = (const float*)d_in[12]; p.ec_w_up = (const float*)d_in[13];
  p.ec_w_down = (const float*)d_in[14]; p.ln_ffn_g = (const float*)d_in[15];
  p.ln_ffn_b = (const float*)d_in[16];
  p.out = (float*)d_out;
  p.ws = (char*)d_ws;
  if (ws_size < WS_NEEDED) { fprintf(stderr, "workspace too small: %zu < %zu\n", ws_size, (size_t)WS_NEEDED); return; }
  static int grid_blocks = 0;
  if (!grid_blocks) {
    int dev = 0, cus = 0, per_cu = 0;
    hipGetDevice(&dev);
    hipDeviceGetAttribute(&cus, hipDeviceAttributeMultiprocessorCount, dev);
    hipFuncSetAttribute((const void*)hybrid_mega, hipFuncAttributeMaxDynamicSharedMemorySize, SMEM_BYTES);
    hipOccupancyMaxActiveBlocksPerMultiprocessor(&per_cu, hybrid_mega, NTHR, SMEM_BYTES);
    if (per_cu < 1) per_cu = 1;
    if (per_cu > 1) per_cu = 1;
    grid_blocks = cus * per_cu;
  }
  hipMemsetAsync((char*)d_ws + OFF_BAR, 0, XCD_BAR_WORDS * 4, stream);
#if MULTI_LAUNCH
  for (int ph = 0; ph < (DBG_STOP ? DBG_STOP : NPHASES); ++ph) {
    hipLaunchKernelGGL(hybrid_mega, dim3(grid_blocks), dim3(NTHR), SMEM_BYTES, stream, p, ph, ph + 1);
  }
  if (DBG_STOP) hipLaunchKernelGGL(dbg_dump, dim3(grid_blocks), dim3(256), 0, stream, p);
#else
  int lo = 0, hi = NPHASES;
  void* args[] = {&p, &lo, &hi};
  hipError_t e = hipLaunchCooperativeKernel((void*)hybrid_mega, dim3(grid_blocks), dim3(NTHR), args, SMEM_BYTES, stream);
  if (e != hipSuccess) fprintf(stderr, "cooperative launch failed: %s (grid %d)\n", hipGetErrorString(e), grid_blocks);
#endif
}
```
